# Optimizing an MI355X kernel written in HIP

```python
import math
import numpy as np
import jax
import jax.numpy as jnp
from jax import lax

D_MODEL = 1024
BATCH = 2
SEQ = 16384
DEPTH = 1
DEC_BATCH = 32
DEC_SEQ = 32
PAST_LEN = 2048

CHUNK = 64
N_MEM = 256
EPS = 1e-6
SSD_WIDTH = D_MODEL // 2
SSD_HEAD_DIM = 64
SSD_HEADS = SSD_WIDTH // SSD_HEAD_DIM
SSD_GROUPS = 2
SSD_STATE = 128
CONV_WIDTH = 4
CONV_DIM = SSD_WIDTH + 2 * SSD_GROUPS * SSD_STATE
DIFF_WIDTH = D_MODEL - SSD_WIDTH
DIFF_HEADS = 4
DIFF_V_DIM = DIFF_WIDTH // DIFF_HEADS
DIFF_QK_DIM = DIFF_V_DIM // 2
ROT_DIM = DIFF_QK_DIM // 4
ROPE_THETA = 500000.0
Q_BLOCK = 128
MEM_HEADS = 4
MEM_HEAD_DIM = D_MODEL // MEM_HEADS
N_KEYS = 128
N_EXPERTS = N_KEYS * N_KEYS
PEER_HEADS = 8
PEER_QUERY_DIM = 256
PEER_HALF = PEER_QUERY_DIM // 2
PEER_TOPK = 16
PEER_TOKEN_BLOCK = 128
IN_SIZES = (SSD_WIDTH, CONV_DIM, SSD_HEADS, DIFF_HEADS * 2 * DIFF_QK_DIM, DIFF_HEADS * 2 * DIFF_QK_DIM, DIFF_HEADS * DIFF_V_DIM)
IN_DIM = sum(IN_SIZES)
IN_SPLITS = tuple(int(s) for s in np.cumsum(IN_SIZES)[:-1])

kernel_name = 'hybrid_ssd_diffattn_peer_streaming_step'


def rmsnorm(x, g):
    xf = x.astype(jnp.float32)
    r = xf * lax.rsqrt(jnp.mean(xf * xf, axis=-1, keepdims=True) + EPS)
    return (r * g.astype(jnp.float32)).astype(x.dtype)


def rope_partial(t, pos):
    half = ROT_DIM // 2
    inv = 1.0 / (ROPE_THETA ** (jnp.arange(half, dtype=jnp.float32) / half))
    ang = pos[:, None] * inv[None, :]
    cos = jnp.cos(ang)[None, :, None, None, :].astype(t.dtype)
    sin = jnp.sin(ang)[None, :, None, None, :].astype(t.dtype)
    t1 = t[..., :half]
    t2 = t[..., half:ROT_DIM]
    return jnp.concatenate([t1 * cos - t2 * sin, t2 * cos + t1 * sin, t[..., ROT_DIM:]], axis=-1)


def causal_conv(xbc, prev, w, b):
    L = xbc.shape[1]
    xpad = jnp.concatenate([prev.astype(xbc.dtype), xbc], axis=1)
    out = b + sum(xpad[:, j:j + L] * w[j] for j in range(CONV_WIDTH))
    return jax.nn.silu(out), xpad[:, -(CONV_WIDTH - 1):]


def ssd_scan(x, dt, a, b_in, c_in, d_skip, h0):
    f32 = jnp.float32
    bsz, L = x.shape[:2]
    q = min(CHUNK, L)
    nc = L // q
    rep = SSD_HEADS // SSD_GROUPS
    xf = x.astype(f32)
    bh = jnp.repeat(b_in.astype(f32), rep, axis=2)
    ch = jnp.repeat(c_in.astype(f32), rep, axis=2)
    xdt = xf * dt[..., None]
    da = dt * a
    blk = lambda t: t.reshape((bsz, nc, q) + t.shape[2:])
    xdt, bh, ch, da = blk(xdt), blk(bh), blk(ch), blk(da)
    a_cum = jnp.cumsum(da, axis=2)
    seg = a_cum[:, :, :, None, :] - a_cum[:, :, None, :, :]
    causal = jnp.tril(jnp.ones((q, q), dtype=bool))[None, None, :, :, None]
    decay = jnp.exp(jnp.where(causal, seg, -jnp.inf))
    cb = jnp.einsum('bcihn,bcjhn->bcijh', ch, bh)
    y_diag = jnp.einsum('bcijh,bcjhp->bcihp', cb * decay, xdt)
    to_end = jnp.exp(a_cum[:, :, -1:, :] - a_cum)
    states = jnp.einsum('bcjhn,bcjh,bcjhp->bchpn', bh, to_end, xdt)
    chunk_decay = jnp.exp(a_cum[:, :, -1, :])

    def step(h, inp):
        s, dec = inp
        return h * dec[:, :, None, None] + s, h

    h_last, h_in = lax.scan(step, h0.astype(f32), (jnp.moveaxis(states, 1, 0), jnp.moveaxis(chunk_decay, 1, 0)))
    h_in = jnp.moveaxis(h_in, 0, 1)
    y_off = jnp.einsum('bcihn,bchpn,bcih->bcihp', ch, h_in, jnp.exp(a_cum))
    y = (y_diag + y_off).reshape(bsz, L, SSD_HEADS, SSD_HEAD_DIM) + d_skip.astype(f32)[:, None] * xf
    return y.astype(x.dtype), h_last


def diff_weights(s, lam):
    p = jax.nn.softmax(s, axis=-1)
    return p[:, :, 0] - lam * p[:, :, 1]


def diff_attn_blockwise(q, k, v, lam):
    bsz, S = q.shape[:2]
    nblk = S // Q_BLOCK
    scale = 1.0 / math.sqrt(DIFF_QK_DIM)
    qb = jnp.swapaxes(q.reshape((bsz, nblk, Q_BLOCK) + q.shape[2:]), 0, 1)
    key_chunk = jnp.arange(S) // CHUNK

    def one(args):
        qi, bi = args
        q_chunk = (bi * Q_BLOCK + jnp.arange(Q_BLOCK)) // CHUNK
        mask = key_chunk[None, :] <= q_chunk[:, None]
        s = jnp.einsum('bqhcd,bkhcd->bhcqk', qi, k).astype(jnp.float32) * scale
        s = jnp.where(mask, s, -jnp.inf)
        a = diff_weights(s, lam)
        return jnp.einsum('bhqk,bkhd->bqhd', a.astype(v.dtype), v)

    out = lax.map(one, (qb, jnp.arange(nblk)))
    return jnp.swapaxes(out, 0, 1).reshape(bsz, S, DIFF_HEADS, DIFF_V_DIM)


def diff_attn_dense(q, k, v, lam):
    s = jnp.einsum('bqhcd,bkhcd->bhcqk', q, k).astype(jnp.float32) / math.sqrt(DIFF_QK_DIM)
    a = diff_weights(s, lam)
    return jnp.einsum('bhqk,bkhd->bqhd', a.astype(v.dtype), v)


def memory_kv(mem, g, w_k, w_v):
    m = rmsnorm(mem, g)
    shp = mem.shape[:2] + (MEM_HEADS, MEM_HEAD_DIM)
    return (m @ w_k).reshape(shp), (m @ w_v).reshape(shp)


def peer_ffn(h, w_pq, sub_keys, u_tab, v_tab):
    bsz, L, d = h.shape
    n = bsz * L
    nblk = -(-n // PEER_TOKEN_BLOCK)
    t = jnp.pad(h.reshape(n, d), ((0, nblk * PEER_TOKEN_BLOCK - n), (0, 0)))

    def one(tb):
        qy = (tb @ w_pq).reshape(tb.shape[0], PEER_HEADS, 2, PEER_HALF)
        s = jnp.einsum('thcd,hcnd->thcn', qy, sub_keys).astype(jnp.float32)
        s1, i1 = lax.top_k(s[:, :, 0], PEER_TOPK)
        s2, i2 = lax.top_k(s[:, :, 1], PEER_TOPK)
        comb = (s1[..., :, None] + s2[..., None, :]).reshape(tb.shape[0], PEER_HEADS, PEER_TOPK * PEER_TOPK)
        sv, si = lax.top_k(comb, PEER_TOPK)
        e = jnp.take_along_axis(i1, si // PEER_TOPK, axis=-1) * N_KEYS + jnp.take_along_axis(i2, si % PEER_TOPK, axis=-1)
        g = jax.nn.softmax(sv, axis=-1)
        act = jax.nn.gelu(jnp.einsum('thkd,td->thk', u_tab[e], tb).astype(jnp.float32)) * g
        return jnp.einsum('thk,thkd->td', act.astype(tb.dtype), v_tab[e])

    out = lax.map(one, t.reshape(nblk, PEER_TOKEN_BLOCK, d))
    return out.reshape(-1, d)[:n].reshape(bsz, L, d)


def trunk_layer(x, pos_offset, k_past, v_past, h0, conv_prev, mem_k, mem_v, p, lambda_init):
    f32 = jnp.float32
    bsz, L, _ = x.shape
    h = rmsnorm(x, p['g_mix'])
    z, xbc, dt_raw, q, k, v = jnp.split(h @ p['w_in'], IN_SPLITS, axis=-1)
    xbc, conv_new = causal_conv(xbc, conv_prev, p['conv_w'], p['conv_b'])
    xs, b_in, c_in = jnp.split(xbc, (SSD_WIDTH, SSD_WIDTH + SSD_GROUPS * SSD_STATE), axis=-1)
    dt = jax.nn.softplus(dt_raw.astype(f32) + p['dt_bias'].astype(f32))
    a = -jnp.exp(p['a_log'].astype(f32))
    y_ssd, h_last = ssd_scan(xs.reshape(bsz, L, SSD_HEADS, SSD_HEAD_DIM), dt, a,
                             b_in.reshape(bsz, L, SSD_GROUPS, SSD_STATE),
                             c_in.reshape(bsz, L, SSD_GROUPS, SSD_STATE), p['d_skip'], h0)
    y_ssd = rmsnorm(y_ssd.reshape(bsz, L, SSD_WIDTH) * jax.nn.silu(z), p['g_ssd'])
    pos = jnp.arange(L, dtype=f32) + pos_offset
    q = rope_partial(q.reshape(bsz, L, DIFF_HEADS, 2, DIFF_QK_DIM), pos)
    k = rope_partial(k.reshape(bsz, L, DIFF_HEADS, 2, DIFF_QK_DIM), pos)
    v = v.reshape(bsz, L, DIFF_HEADS, DIFF_V_DIM)
    lam = (jnp.exp(jnp.sum(p['lam_q1'].astype(f32) * p['lam_k1'].astype(f32)))
           - jnp.exp(jnp.sum(p['lam_q2'].astype(f32) * p['lam_k2'].astype(f32))) + lambda_init)
    if k_past is None:
        o = diff_attn_blockwise(q, k, v, lam)
    else:
        n_past = k_past.shape[1]
        k_all = jnp.concatenate([k_past.reshape(bsz, n_past, DIFF_HEADS, 2, DIFF_QK_DIM).astype(k.dtype), k], axis=1)
        v_all = jnp.concatenate([v_past.astype(v.dtype), v], axis=1)
        o = diff_attn_dense(q, k_all, v_all, lam)
    o = rmsnorm(o, p['g_subln']) * (1.0 - lambda_init)
    mixed = jnp.concatenate([y_ssd, o.reshape(bsz, L, DIFF_WIDTH).astype(y_ssd.dtype)], axis=-1)
    x = x + mixed @ p['w_out']
    qm = (rmsnorm(x, p['g_mem_q']) @ p['w_mq']).reshape(bsz, L, MEM_HEADS, MEM_HEAD_DIM)
    sm = jnp.einsum('blhd,bmhd->bhlm', qm, mem_k.astype(qm.dtype)).astype(f32) / math.sqrt(MEM_HEAD_DIM)
    pm = jax.nn.softmax(sm, axis=-1).astype(x.dtype)
    om = jnp.einsum('bhlm,bmhd->blhd', pm, mem_v.astype(x.dtype)).reshape(bsz, L, D_MODEL)
    x = x + om @ p['w_mo']
    x = x + peer_ffn(rmsnorm(x, p['g_ffn']), p['w_pq'], p['peer_keys'], p['peer_u'], p['peer_v'])
    k_rows = k.reshape(bsz, L, DIFF_HEADS, 2 * DIFF_QK_DIM)
    return x, k_rows, v, h_last.astype(x.dtype), conv_new


def setup_inputs(seed: int = 0) -> dict:
    key = jax.random.key(seed)
    ks = iter(jax.random.split(key, 48))
    f32 = jnp.float32
    nrm = lambda shape, scale: jax.random.normal(next(ks), shape, f32) * scale
    gain = lambda shape: 1.0 + 0.02 * jax.random.normal(next(ks), shape, f32)
    dsc = D_MODEL ** -0.5
    x_prompt = nrm((BATCH, SEQ, D_MODEL), 1.0)
    x_sample = nrm((DEC_BATCH, DEC_SEQ, D_MODEL), 1.0)
    cache_attn_k = nrm((DEPTH, DEC_BATCH, PAST_LEN, DIFF_HEADS, 2 * DIFF_QK_DIM), 1.0)
    cache_attn_v = nrm((DEPTH, DEC_BATCH, PAST_LEN, DIFF_HEADS, DIFF_V_DIM), 1.0)
    cache_mem_k = nrm((DEPTH, DEC_BATCH, N_MEM, MEM_HEADS, MEM_HEAD_DIM), 1.0)
    cache_mem_v = nrm((DEPTH, DEC_BATCH, N_MEM, MEM_HEADS, MEM_HEAD_DIM), 1.0)
    state_ssm = nrm((DEPTH, DEC_BATCH, SSD_HEADS, SSD_HEAD_DIM, SSD_STATE), 0.1)
    state_conv = nrm((DEPTH, DEC_BATCH, CONV_WIDTH - 1, CONV_DIM), 1.0)
    mem_prompt = nrm((BATCH, N_MEM, D_MODEL), 1.0)
    g_mix = gain((DEPTH, D_MODEL))
    w_in = nrm((DEPTH, D_MODEL, IN_DIM), dsc)
    conv_w = nrm((DEPTH, CONV_WIDTH, CONV_DIM), CONV_WIDTH ** -0.5)
    conv_b = nrm((DEPTH, CONV_DIM), 0.01)
    dt0 = jnp.exp(jax.random.uniform(next(ks), (DEPTH, SSD_HEADS), f32, math.log(1e-3), math.log(1e-1)))
    dt_bias = dt0 + jnp.log(-jnp.expm1(-dt0))
    a_log = jnp.log(jax.random.uniform(next(ks), (DEPTH, SSD_HEADS), f32, 1.0, 16.0))
    d_skip = gain((DEPTH, SSD_HEADS))
    g_ssd = gain((DEPTH, SSD_WIDTH))
    lam_q1 = nrm((DEPTH, DIFF_QK_DIM), 0.1)
    lam_k1 = nrm((DEPTH, DIFF_QK_DIM), 0.1)
    lam_q2 = nrm((DEPTH, DIFF_QK_DIM), 0.1)
    lam_k2 = nrm((DEPTH, DIFF_QK_DIM), 0.1)
    g_subln = gain((DEPTH, DIFF_V_DIM))
    w_out = nrm((DEPTH, D_MODEL, D_MODEL), dsc)
    g_mem_q = gain((DEPTH, D_MODEL))
    g_mem_kv = gain((DEPTH, D_MODEL))
    w_mq = nrm((DEPTH, D_MODEL, D_MODEL), dsc)
    w_mk = nrm((DEPTH, D_MODEL, D_MODEL), dsc)
    w_mv = nrm((DEPTH, D_MODEL, D_MODEL), dsc)
    w_mo = nrm((DEPTH, D_MODEL, D_MODEL), dsc)
    g_ffn = gain((DEPTH, D_MODEL))
    w_pq = nrm((DEPTH, D_MODEL, PEER_HEADS * PEER_QUERY_DIM), dsc)
    peer_keys = nrm((DEPTH, PEER_HEADS, 2, N_KEYS, PEER_HALF), PEER_HALF ** -0.5)
    peer_u = nrm((DEPTH, N_EXPERTS, D_MODEL), dsc)
    peer_v = nrm((DEPTH, N_EXPERTS, D_MODEL), (PEER_HEADS * PEER_TOPK) ** -0.5)
    g_final = gain((D_MODEL,))
    return {'x_prompt': x_prompt, 'x_sample': x_sample, 'cache_attn_k': cache_attn_k, 'cache_attn_v': cache_attn_v,
            'cache_mem_k': cache_mem_k, 'cache_mem_v': cache_mem_v, 'state_ssm': state_ssm, 'state_conv': state_conv,
            'mem_prompt': mem_prompt, 'g_mix': g_mix, 'w_in': w_in, 'conv_w': conv_w, 'conv_b': conv_b,
            'dt_bias': dt_bias, 'a_log': a_log, 'd_skip': d_skip, 'g_ssd': g_ssd, 'lam_q1': lam_q1, 'lam_k1': lam_k1,
            'lam_q2': lam_q2, 'lam_k2': lam_k2, 'g_subln': g_subln, 'w_out': w_out, 'g_mem_q': g_mem_q,
            'g_mem_kv': g_mem_kv, 'w_mq': w_mq, 'w_mk': w_mk, 'w_mv': w_mv, 'w_mo': w_mo, 'g_ffn': g_ffn,
            'w_pq': w_pq, 'peer_keys': peer_keys, 'peer_u': peer_u, 'peer_v': peer_v, 'g_final': g_final}


def reference(x_prompt, x_sample, cache_attn_k, cache_attn_v, cache_mem_k, cache_mem_v, state_ssm, state_conv,
              mem_prompt, g_mix, w_in, conv_w, conv_b, dt_bias, a_log, d_skip, g_ssd, lam_q1, lam_k1, lam_q2, lam_k2,
              g_subln, w_out, g_mem_q, g_mem_kv, w_mq, w_mk, w_mv, w_mo, g_ffn, w_pq, peer_keys, peer_u, peer_v,
              g_final):
    xp = x_prompt
    xs = x_sample
    bp = xp.shape[0]
    past_len = cache_attn_k.shape[2]
    kp_l, vp_l, hp_l, cp_l, mkp_l, mvp_l = [], [], [], [], [], []
    ks_l, vs_l, hs_l, cs_l = [], [], [], []
    for l in range(DEPTH):
        p = {'g_mix': g_mix[l], 'w_in': w_in[l], 'conv_w': conv_w[l], 'conv_b': conv_b[l], 'dt_bias': dt_bias[l],
             'a_log': a_log[l], 'd_skip': d_skip[l], 'g_ssd': g_ssd[l], 'lam_q1': lam_q1[l], 'lam_k1': lam_k1[l],
             'lam_q2': lam_q2[l], 'lam_k2': lam_k2[l], 'g_subln': g_subln[l], 'w_out': w_out[l],
             'g_mem_q': g_mem_q[l], 'w_mq': w_mq[l], 'w_mo': w_mo[l], 'g_ffn': g_ffn[l], 'w_pq': w_pq[l],
             'peer_keys': peer_keys[l], 'peer_u': peer_u[l], 'peer_v': peer_v[l]}
        lambda_init = 0.8 - 0.6 * math.exp(-0.3 * l)
        mk_p, mv_p = memory_kv(mem_prompt, g_mem_kv[l], w_mk[l], w_mv[l])
        h0_p = jnp.zeros((bp, SSD_HEADS, SSD_HEAD_DIM, SSD_STATE), jnp.float32)
        conv0_p = jnp.zeros((bp, CONV_WIDTH - 1, CONV_DIM), xp.dtype)
        xp, kp, vp, hp, cp = trunk_layer(xp, 0, None, None, h0_p, conv0_p, mk_p, mv_p, p, lambda_init)
        xs, ksn, vsn, hsn, csn = trunk_layer(xs, past_len, cache_attn_k[l], cache_attn_v[l], state_ssm[l],
                                             state_conv[l], cache_mem_k[l], cache_mem_v[l], p, lambda_init)
        kp_l.append(kp); vp_l.append(vp); hp_l.append(hp); cp_l.append(cp); mkp_l.append(mk_p); mvp_l.append(mv_p)
        ks_l.append(ksn); vs_l.append(vsn); hs_l.append(hsn); cs_l.append(csn)
    y_prompt = rmsnorm(xp, g_final)
    y_sample = rmsnorm(xs, g_final)
    return (y_prompt, y_sample, jnp.stack(kp_l), jnp.stack(vp_l), jnp.stack(hp_l), jnp.stack(cp_l),
            jnp.stack(mkp_l), jnp.stack(mvp_l), jnp.stack(ks_l), jnp.stack(vs_l), jnp.stack(hs_l), jnp.stack(cs_l))
```

```cpp
#include <hip/hip_runtime.h>
#include <hip/hip_cooperative_groups.h>
#include <stdint.h>
#include <cstdio>
namespace cg = cooperative_groups;

#ifndef MEGA
#define MEGA 1
#endif
#ifndef REPEAT_PHASE
#define REPEAT_PHASE -1
#endif
#define RP(n) if (REPEAT_PHASE == n) { run_phase<n>(P, smem, &s_item, 1); grid.sync(); }

typedef unsigned short bf16_t;
typedef __bf16 bf2_t __attribute__((ext_vector_type(2)));
typedef float f2_t __attribute__((ext_vector_type(2)));
using bf16x8 = __attribute__((ext_vector_type(8))) short;
using f32x16 = __attribute__((ext_vector_type(16))) float;
using u32x4 = __attribute__((ext_vector_type(4))) unsigned;
using u32x2 = __attribute__((ext_vector_type(2))) unsigned;
#define DI __device__ __forceinline__
#define MFMA(a, b, c) __builtin_amdgcn_mfma_f32_32x32x16_bf16((a), (b), (c), 0, 0, 0)

constexpr int TP = 32768, TS = 1024, TT = TP + TS, SEQ = 16384, KSL = 2112, NKS = 2080;
constexpr size_t O_YP = 0, O_YS = 33554432, O_KP = 34603008, O_VP = 51380224, O_SSMP = 68157440, O_CONVP = 68288512,
                 O_MKP = 68294656, O_MVP = 68818944, O_KS = 69343232, O_VS = 69867520, O_SSMS = 70391808, O_CONVS = 72488960;
constexpr int SMEM_BYTES = 70656;
constexpr float EPSF = 1e-6f;

struct Params {
  const float *x_prompt, *x_sample, *cache_k, *cache_v, *cache_mk, *cache_mv, *state_ssm, *state_conv, *mem_prompt;
  const float *g_mix, *w_in, *conv_w, *conv_b, *dt_bias, *a_log, *d_skip, *g_ssd, *lam_q1, *lam_k1, *lam_q2, *lam_k2, *g_subln,
      *w_out, *g_mem_q, *g_mem_kv, *w_mq, *w_mk, *w_mv, *w_mo, *g_ffn, *w_pq, *peer_keys, *peer_u, *peer_v, *g_final;
  float* out;
  float* xres;
  bf16_t *WinT, *WoutT, *WmqT, *WmkvT, *WmoT, *WpqT, *keysB, *Ub, *Vb, *mkS, *mvTS, *mnP, *mkP, *mvTP;
  bf16_t *R1, *R2, *kS, *vTS, *zb, *qb, *kP, *vTP, *qy, *SH, *Cpost;
  float *dtb, *ssqp, *rope, *lamp, *rinv, *topS, *acb;
  int* topI;
  unsigned* counters;
};

struct KArgs {
  const float* in[35];
  float* out;
  char* ws;
};

__host__ __device__ inline Params make_params(const KArgs& A, size_t* total) {
  Params P{};
  const float* const* in = A.in;
  P.x_prompt = in[0]; P.x_sample = in[1]; P.cache_k = in[2]; P.cache_v = in[3]; P.cache_mk = in[4]; P.cache_mv = in[5];
  P.state_ssm = in[6]; P.state_conv = in[7]; P.mem_prompt = in[8]; P.g_mix = in[9]; P.w_in = in[10]; P.conv_w = in[11];
  P.conv_b = in[12]; P.dt_bias = in[13]; P.a_log = in[14]; P.d_skip = in[15]; P.g_ssd = in[16]; P.lam_q1 = in[17];
  P.lam_k1 = in[18]; P.lam_q2 = in[19]; P.lam_k2 = in[20]; P.g_subln = in[21]; P.w_out = in[22]; P.g_mem_q = in[23];
  P.g_mem_kv = in[24]; P.w_mq = in[25]; P.w_mk = in[26]; P.w_mv = in[27]; P.w_mo = in[28]; P.g_ffn = in[29]; P.w_pq = in[30];
  P.peer_keys = in[31]; P.peer_u = in[32]; P.peer_v = in[33]; P.g_final = in[34];
  P.out = A.out;
  P.xres = A.out;
  char* ws = A.ws;
  size_t off = 0;
  auto alloc = [&](size_t bytes) { char* p = ws + off; off += (bytes + 255) & ~(size_t)255; return p; };
  P.WinT = (bf16_t*)alloc((size_t)3200 * 1024 * 2);
  P.WoutT = (bf16_t*)alloc((size_t)1024 * 1024 * 2);
  P.WmqT = (bf16_t*)alloc((size_t)1024 * 1024 * 2);
  P.WmkvT = (bf16_t*)alloc((size_t)2048 * 1024 * 2);
  P.WmoT = (bf16_t*)alloc((size_t)1024 * 1024 * 2);
  P.WpqT = (bf16_t*)alloc((size_t)2048 * 1024 * 2);
  P.keysB = (bf16_t*)alloc((size_t)16 * 128 * 128 * 2);
  P.Ub = (bf16_t*)alloc((size_t)16384 * 1024 * 2);
  P.Vb = (bf16_t*)alloc((size_t)16384 * 1024 * 2);
  P.mkS = (bf16_t*)alloc((size_t)32 * 256 * 1024 * 2);
  P.mvTS = (bf16_t*)alloc((size_t)32 * 256 * 1024 * 2);
  P.mnP = (bf16_t*)alloc((size_t)512 * 1024 * 2);
  P.mkP = (bf16_t*)alloc((size_t)512 * 1024 * 2);
  P.mvTP = (bf16_t*)alloc((size_t)512 * 1024 * 2);
  P.R1 = (bf16_t*)alloc((size_t)TT * 1024 * 2);
  P.R2 = (bf16_t*)alloc((size_t)TT * 1024 * 2);
  P.kS = (bf16_t*)alloc((size_t)32 * KSL * 512 * 2);
  P.vTS = (bf16_t*)alloc((size_t)32 * KSL * 512 * 2);
  char* r4 = alloc((size_t)TT * 2048 * 2);
  P.qy = (bf16_t*)r4;
  P.zb = (bf16_t*)r4;
  P.qb = P.zb + (size_t)TT * 512;
  P.kP = P.qb + (size_t)TT * 512;
  P.vTP = P.kP + (size_t)TP * 512;
  P.dtb = (float*)alloc((size_t)TT * 8 * 4);
  P.ssqp = (float*)alloc((size_t)TT * 16 * 4);
  P.rope = (float*)alloc((size_t)16416 * 16 * 4);
  P.rinv = (float*)alloc((size_t)TT * 4);
  P.lamp = (float*)alloc(256);
  P.counters = (unsigned*)alloc(256);
  P.SH = (bf16_t*)A.out;
  P.Cpost = P.SH + (size_t)16 * 256 * 8192;
  P.acb = (float*)(P.Cpost + (size_t)TT * 256);
  P.topS = (float*)P.R2;
  P.topI = (int*)(P.R2 + (size_t)TT * 512);
  if (total) *total = off;
  return P;
}

template <int V> struct IC { static constexpr int value = V; constexpr operator int() const { return V; } };
template <int N, class F> DI void static_for(F&& f) {
  if constexpr (N > 0) { static_for<N - 1>(f); f(IC<N - 1>{}); }
}
DI int TID() { int t = threadIdx.x; asm volatile("" : "+v"(t)); return t; }
DI unsigned pack2(float a, float b) {
  f2_t v = {a, b};
  return __builtin_bit_cast(unsigned, __builtin_convertvector(v, bf2_t));
}
DI bf16_t f2bf(float a) { return (bf16_t)(pack2(a, 0.f) & 0xffffu); }
DI float bf2f(bf16_t b) { return __uint_as_float(((unsigned)b) << 16); }
DI float bflo(unsigned u) { return __uint_as_float(u << 16); }
DI float bfhi(unsigned u) { return __uint_as_float(u & 0xffff0000u); }
DI int crow(int reg, int h) { return (reg & 3) + 8 * (reg >> 2) + 4 * h; }
DI bf16x8 pack8(const f32x16& x, int s) {
  u32x4 p;
  p[0] = pack2(x[8 * s], x[8 * s + 1]);
  p[1] = pack2(x[8 * s + 2], x[8 * s + 3]);
  p[2] = pack2(x[8 * s + 4], x[8 * s + 5]);
  p[3] = pack2(x[8 * s + 6], x[8 * s + 7]);
  return __builtin_bit_cast(bf16x8, p);
}
DI bf16x8 ld16(const bf16_t* p) { return *(const bf16x8*)p; }
DI bf16x8 ld8x2(const bf16_t* p0, const bf16_t* p1) {
  u32x2 a = *(const u32x2*)p0, b = *(const u32x2*)p1;
  u32x4 v = {a[0], a[1], b[0], b[1]};
  return __builtin_bit_cast(bf16x8, v);
}
DI float wave_sum(float v) {
#pragma unroll
  for (int o = 32; o; o >>= 1) v += __shfl_xor(v, o);
  return v;
}
DI unsigned wave_max_u(unsigned v) {
#pragma unroll
  for (int o = 32; o; o >>= 1) {
    unsigned t = (unsigned)__shfl_xor((int)v, o);
    v = v > t ? v : t;
  }
  return v;
}
DI float fexp2(float x) { return __builtin_amdgcn_exp2f(x); }
DI float half_max(float v) {
  auto r = __builtin_amdgcn_permlane32_swap(__float_as_uint(v), __float_as_uint(v), false, false);
  return fmaxf(__uint_as_float(r[0]), __uint_as_float(r[1]));
}
DI float half_sum(float v) {
  auto r = __builtin_amdgcn_permlane32_swap(__float_as_uint(v), __float_as_uint(v), false, false);
  return __uint_as_float(r[0]) + __uint_as_float(r[1]);
}
DI float siluf(float x) { return x / (1.f + __expf(-x)); }
DI unsigned sortable(float f) {
  unsigned u = __float_as_uint(f);
  return (u & 0x80000000u) ? ~u : (u | 0x80000000u);
}
DI float unsortable(unsigned s) {
  unsigned u = (s & 0x80000000u) ? (s & 0x7fffffffu) : ~s;
  return __uint_as_float(u);
}

DI void wT(const float* __restrict__ src, int ld, int c0, bf16_t* __restrict__ dst, int nrows, int gtid, int gsz) {
  for (int idx = gtid; idx < nrows * 128; idx += gsz) {
    int n = idx % nrows, k8 = idx / nrows;
    const float* s = src + (size_t)(k8 * 8) * ld + c0 + n;
    u32x4 v;
    v[0] = pack2(s[0], s[ld]);
    v[1] = pack2(s[2 * (size_t)ld], s[3 * (size_t)ld]);
    v[2] = pack2(s[4 * (size_t)ld], s[5 * (size_t)ld]);
    v[3] = pack2(s[6 * (size_t)ld], s[7 * (size_t)ld]);
    *(u32x4*)(dst + (size_t)n * 1024 + k8 * 8) = v;
  }
}
DI void cvt4(const float* __restrict__ src, bf16_t* __restrict__ dst, size_t n4, int gtid, int gsz) {
  for (size_t i = gtid; i < n4; i += gsz) {
    float4 v = ((const float4*)src)[i];
    u32x2 o = {pack2(v.x, v.y), pack2(v.z, v.w)};
    ((u32x2*)dst)[i] = o;
  }
}

DI void cvt8(const float* __restrict__ src, unsigned* __restrict__ dst, size_t n4, float scale, int gtid, int gsz) {
  for (size_t i = gtid; i < n4; i += gsz) {
    float4 v = ((const float4*)src)[i];
    const float a = fminf(fmaxf(v.x * scale, -448.f), 448.f), b = fminf(fmaxf(v.y * scale, -448.f), 448.f);
    const float c = fminf(fmaxf(v.z * scale, -448.f), 448.f), d = fminf(fmaxf(v.w * scale, -448.f), 448.f);
    int pk = __builtin_amdgcn_cvt_pk_fp8_f32(a, b, 0, false);
    pk = __builtin_amdgcn_cvt_pk_fp8_f32(c, d, pk, true);
    dst[i] = (unsigned)pk;
  }
}

DI void phaseA(const Params& P) {
  const int tid = TID(), gtid = blockIdx.x * 256 + tid, gsz = gridDim.x * 256;
  const int lane = tid & 63;
  const u32x4 z4 = {0u, 0u, 0u, 0u};
  if (gtid == 0) {
    float s1 = 0.f, s2 = 0.f;
    for (int i = 0; i < 64; ++i) { s1 += P.lam_q1[i] * P.lam_k1[i]; s2 += P.lam_q2[i] * P.lam_k2[i]; }
    P.lamp[0] = expf(s1) - expf(s2) + 0.2f;
    for (int i = 0; i < 32; ++i) P.counters[i] = 0u;
  }
  {
    const int gw = gtid >> 6, nw = gsz >> 6;
    for (int row = gw; row < TT + 512; row += nw) {
      const float* src; const float* g; bf16_t* dst;
      if (row < TP) { src = P.x_prompt + (size_t)row * 1024; g = P.g_mix; dst = P.R1 + (size_t)row * 1024; }
      else if (row < TT) { src = P.x_sample + (size_t)(row - TP) * 1024; g = P.g_mix; dst = P.R1 + (size_t)row * 1024; }
      else { src = P.mem_prompt + (size_t)(row - TT) * 1024; g = P.g_mem_kv; dst = P.mnP + (size_t)(row - TT) * 1024; }
      const float4* s4 = (const float4*)src; const float4* g4 = (const float4*)g;
      float4 a0 = s4[lane * 2], a1 = s4[lane * 2 + 1], b0 = s4[128 + lane * 2], b1 = s4[128 + lane * 2 + 1];
      float ss = a0.x * a0.x + a0.y * a0.y + a0.z * a0.z + a0.w * a0.w + a1.x * a1.x + a1.y * a1.y + a1.z * a1.z + a1.w * a1.w +
                 b0.x * b0.x + b0.y * b0.y + b0.z * b0.z + b0.w * b0.w + b1.x * b1.x + b1.y * b1.y + b1.z * b1.z + b1.w * b1.w;
      ss = wave_sum(ss);
      const float ri = rsqrtf(ss * (1.f / 1024.f) + EPSF);
      float4 ga0 = g4[lane * 2], ga1 = g4[lane * 2 + 1], gb0 = g4[128 + lane * 2], gb1 = g4[128 + lane * 2 + 1];
      u32x4 o0 = {pack2(a0.x * ri * ga0.x, a0.y * ri * ga0.y), pack2(a0.z * ri * ga0.z, a0.w * ri * ga0.w),
                  pack2(a1.x * ri * ga1.x, a1.y * ri * ga1.y), pack2(a1.z * ri * ga1.z, a1.w * ri * ga1.w)};
      u32x4 o1 = {pack2(b0.x * ri * gb0.x, b0.y * ri * gb0.y), pack2(b0.z * ri * gb0.z, b0.w * ri * gb0.w),
                  pack2(b1.x * ri * gb1.x, b1.y * ri * gb1.y), pack2(b1.z * ri * gb1.z, b1.w * ri * gb1.w)};
      *(u32x4*)(dst + lane * 8) = o0;
      *(u32x4*)(dst + 512 + lane * 8) = o1;
    }
  }
  wT(P.w_in, 3080, 0, P.WinT, 1536, gtid, gsz);
  wT(P.w_in, 3080, 1544, P.WinT + (size_t)1536 * 1024, 1536, gtid, gsz);
  wT(P.w_in, 3080, 1536, P.WinT + (size_t)3072 * 1024, 8, gtid, gsz);
  for (int i = gtid; i < 120 * 128; i += gsz) *(u32x4*)(P.WinT + (size_t)3080 * 1024 + (size_t)i * 8) = z4;
  wT(P.w_out, 1024, 0, P.WoutT, 1024, gtid, gsz);
  wT(P.w_mq, 1024, 0, P.WmqT, 1024, gtid, gsz);
  wT(P.w_mk, 1024, 0, P.WmkvT, 1024, gtid, gsz);
  wT(P.w_mv, 1024, 0, P.WmkvT + (size_t)1024 * 1024, 1024, gtid, gsz);
  wT(P.w_mo, 1024, 0, P.WmoT, 1024, gtid, gsz);
  wT(P.w_pq, 2048, 0, P.WpqT, 2048, gtid, gsz);
  for (int i = gtid; i < 16416 * 8; i += gsz) {
    int pi = i >> 3, j = i & 7;
    float pos = (float)(pi < 16384 ? pi : (2048 + pi - 16384));
    float inv = 1.0f / powf(500000.f, (float)j * 0.125f);
    float ang = pos * inv;
    double a = (double)ang;
    a -= 6.283185307179586 * floor(a * 0.15915494309189535);
    float ar = (float)a;
    P.rope[i * 2] = cosf(ar);
    P.rope[i * 2 + 1] = sinf(ar);
  }
  cvt4(P.peer_keys, P.keysB, (size_t)16 * 128 * 128 / 4, gtid, gsz);
  cvt4(P.cache_mk, P.mkS, (size_t)32 * 256 * 1024 / 4, gtid, gsz);
  for (int i = gtid; i < 32 * 4 * 32 * 256; i += gsz) {
    int dv = i & 255, k8 = (i >> 8) & 31, bh = i >> 13, b = bh >> 2, h = bh & 3;
    const float* s = P.cache_mv + (((size_t)b * 256 + k8 * 8) * 4 + h) * 256 + dv;
    u32x4 v = {pack2(s[0], s[1024]), pack2(s[2048], s[3072]), pack2(s[4096], s[5120]), pack2(s[6144], s[7168])};
    *(u32x4*)(P.mvTS + ((size_t)bh * 256 + dv) * 256 + k8 * 8) = v;
  }
  for (size_t i = gtid; i < (size_t)32 * 2048 * 512 / 4; i += gsz) {
    size_t e = i * 4, b = e / (2048 * 512), rem = e % (2048 * 512);
    float4 v = ((const float4*)P.cache_k)[i];
    u32x2 o = {pack2(v.x, v.y), pack2(v.z, v.w)};
    *(u32x2*)(P.kS + b * (size_t)KSL * 512 + rem) = o;
  }
  for (int i = gtid; i < 32 * 32 * 64; i += gsz) {
    int b = i / (32 * 64), rem = i % (32 * 64);
    *(u32x4*)(P.kS + ((size_t)b * KSL + NKS) * 512 + (size_t)rem * 8) = z4;
  }
  for (int i = gtid; i < 32 * 4 * 256 * 128; i += gsz) {
    int dv = i & 127, k8 = (i >> 7) & 255, bh = i >> 15, b = bh >> 2, h = bh & 3;
    const float* s = P.cache_v + (((size_t)b * 2048 + k8 * 8) * 4 + h) * 128 + dv;
    u32x4 v = {pack2(s[0], s[512]), pack2(s[1024], s[1536]), pack2(s[2048], s[2560]), pack2(s[3072], s[3584])};
    *(u32x4*)(P.vTS + ((size_t)bh * 128 + dv) * KSL + k8 * 8) = v;
  }
  for (int i = gtid; i < 128 * 128 * 4; i += gsz) {
    int c = i & 3, row = i >> 2;
    *(u32x4*)(P.vTS + (size_t)row * KSL + NKS + c * 8) = z4;
  }
  cvt8(P.peer_u, (unsigned*)P.Ub, (size_t)16384 * 1024 / 4, 128.f, gtid, gsz);
  cvt8(P.peer_v, (unsigned*)P.Vb, (size_t)16384 * 1024 / 4, 32.f, gtid, gsz);
}

enum { M_IN = 0, M_KV = 1, M_OUT = 2, M_MQ = 3, M_MO = 4, M_PQ = 5 };
DI void peer_scores_core(const Params& P, size_t tok, int hc, const bf16x8 (&qf)[8], int r, int h5);

template <int MODE, int MI>
DI void gemm_tile(const Params& P, const bf16_t* __restrict__ A, const bf16_t* __restrict__ Bt, int m0, int n0, char* smem) {
  constexpr int BM = 64 * MI;
  bf16_t* As = (bf16_t*)smem;
  bf16_t* Bs = As + BM * 72;
  float* rs = (float*)(smem + (MODE == M_PQ ? 69632 : (BM + 128) * 72 * 2));
  const int tid = TID(), lane = tid & 63, w = tid >> 6, r = lane & 31, h = lane >> 5;
  const int wm = w >> 1, wn = w & 1;
  __syncthreads();
  if constexpr (MODE == M_OUT) if (tid < BM) {
    const float4* q = (const float4*)(P.ssqp + (size_t)(m0 + tid) * 16);
    float4 a = q[0], b = q[1], c = q[2], d = q[3];
    float s = a.x + a.y + a.z + a.w + b.x + b.y + b.z + b.w + c.x + c.y + c.z + c.w + d.x + d.y + d.z + d.w;
    rs[tid] = rsqrtf(s * (1.f / 512.f) + EPSF);
  }
  if constexpr (MODE == M_MQ || MODE == M_PQ) if (tid < BM) rs[tid] = P.rinv[m0 + tid];
  f32x16 acc[MI][2];
#pragma unroll
  for (int i = 0; i < MI; ++i)
#pragma unroll
    for (int j = 0; j < 2; ++j)
#pragma unroll
      for (int e = 0; e < 16; ++e) acc[i][j][e] = 0.f;
  u32x4 ra[2 * MI], rb[4];
  const int lrow = tid >> 3, lc = tid & 7;
  const bf16_t* Ag = A + (size_t)(m0 + lrow) * 1024 + lc * 8;
  const bf16_t* Bg = Bt + (size_t)(n0 + lrow) * 1024 + lc * 8;
#pragma unroll
  for (int p = 0; p < 2 * MI; ++p) ra[p] = *(const u32x4*)(Ag + (size_t)p * 32 * 1024);
#pragma unroll
  for (int p = 0; p < 4; ++p) rb[p] = *(const u32x4*)(Bg + (size_t)p * 32 * 1024);
  for (int kt = 0; kt < 16; ++kt) {
    __syncthreads();
#pragma unroll
    for (int p = 0; p < 2 * MI; ++p) *(u32x4*)(As + (p * 32 + lrow) * 72 + lc * 8) = ra[p];
#pragma unroll
    for (int p = 0; p < 4; ++p) *(u32x4*)(Bs + (p * 32 + lrow) * 72 + lc * 8) = rb[p];
    __syncthreads();
    if (kt + 1 < 16) {
#pragma unroll
      for (int p = 0; p < 2 * MI; ++p) ra[p] = *(const u32x4*)(Ag + (size_t)p * 32 * 1024 + (kt + 1) * 64);
#pragma unroll
      for (int p = 0; p < 4; ++p) rb[p] = *(const u32x4*)(Bg + (size_t)p * 32 * 1024 + (kt + 1) * 64);
    }
    if constexpr (MODE == M_OUT) {
      if (kt == 8) {
#pragma unroll
        for (int i = 0; i < MI; ++i)
#pragma unroll
          for (int e = 0; e < 16; ++e) {
            float sc = rs[wm * (32 * MI) + i * 32 + crow(e, h)];
            acc[i][0][e] *= sc;
            acc[i][1][e] *= sc;
          }
      }
    }
#pragma unroll
    for (int s = 0; s < 4; ++s) {
      if (s == 2) __builtin_amdgcn_sched_barrier(0);
      bf16x8 b0 = ld16(Bs + (wn * 64 + r) * 72 + s * 16 + h * 8);
      bf16x8 b1 = ld16(Bs + (wn * 64 + 32 + r) * 72 + s * 16 + h * 8);
#pragma unroll
      for (int i = 0; i < MI; ++i) {
        bf16x8 a = ld16(As + (wm * (32 * MI) + i * 32 + r) * 72 + s * 16 + h * 8);
        acc[i][0] = MFMA(a, b0, acc[i][0]);
        acc[i][1] = MFMA(a, b1, acc[i][1]);
      }
    }
  }
  if constexpr (MODE == M_PQ) {
    static_assert(MODE != M_PQ || MI == 4, "fused scoring expects 256-row tiles");
    __syncthreads();
    bf16_t* Qs = (bf16_t*)smem;
#pragma unroll
    for (int i = 0; i < MI; ++i)
#pragma unroll
      for (int e = 0; e < 16; ++e) {
        const int row = wm * (32 * MI) + i * 32 + crow(e, h);
        const float sc = rs[row];
        Qs[row * 136 + wn * 64 + r] = f2bf(acc[i][0][e] * sc);
        Qs[row * 136 + wn * 64 + 32 + r] = f2bf(acc[i][1][e] * sc);
      }
    __syncthreads();
    const int hc = n0 >> 7;
#pragma unroll 1
    for (int bt = 0; bt < 2; ++bt) {
      const int tokl = w * 64 + bt * 32 + r;
      bf16x8 qf[8];
#pragma unroll
      for (int ks = 0; ks < 8; ++ks) qf[ks] = ld16(Qs + tokl * 136 + ks * 16 + h * 8);
      peer_scores_core(P, (size_t)(m0 + tokl), hc, qf, r, h);
    }
    return;
  }
  int r2 = r, h2 = h;
  asm volatile("" : "+v"(r2), "+v"(h2));
  static_for<MI>([&](auto I_) { static_for<2>([&](auto J_) {
      constexpr int i = decltype(I_)::value, j = decltype(J_)::value;
      const int nb = n0 + wn * 64 + j * 32;
      const int n = nb + r2;
      static_for<4>([&](auto G_) {
        constexpr int g = decltype(G_)::value;
        const int lr = wm * (32 * MI) + i * 32 + 8 * g + 4 * h2;
        const int mb = m0 + lr;
        float v[4] = {acc[i][j][4 * g], acc[i][j][4 * g + 1], acc[i][j][4 * g + 2], acc[i][j][4 * g + 3]};
        float pv[4] = {0.f, 0.f, 0.f, 0.f};
        if constexpr (MODE == M_IN) {
#pragma unroll
          for (int q = 0; q < 4; ++q) pv[q] = __shfl_xor(v[q], 8);
        }
        if constexpr (MODE == M_IN) {
          if (nb < 512) {
#pragma unroll
            for (int q = 0; q < 4; ++q) P.zb[(size_t)(mb + q) * 512 + n] = f2bf(v[q]);
          } else if (nb < 1536) {
            const int c = n - 512;
#pragma unroll
            for (int q = 0; q < 4; ++q) {
              const int t = mb + q;
              P.R2[(size_t)t * 1024 + c] = f2bf(v[q]);
              if (t < TP) {
                int s = t & 16383;
                if (s >= 16381) P.out[O_CONVP + ((size_t)(t >> 14) * 3 + (s - 16381)) * 1024 + c] = v[q];
              } else {
                int ts = t - TP, s = ts & 31;
                if (s >= 29) P.out[O_CONVS + ((size_t)(ts >> 5) * 3 + (s - 29)) * 1024 + c] = v[q];
              }
            }
          } else if (nb < 2560) {
            const bool isK = nb >= 2048;
            const int c = (n - 1536) & 511;
            const int d = c & 63;
            if ((nb & 63) == 0) {
#pragma unroll
              for (int q = 0; q < 4; ++q) {
                const int t = mb + q;
                const int pi = t < TP ? (t & 16383) : (16384 + ((t - TP) & 31));
                const float2 cs = *(const float2*)(P.rope + ((size_t)pi * 8 + (d & 7)) * 2);
                const float rot = d < 8 ? (v[q] * cs.x - pv[q] * cs.y) : (v[q] * cs.x + pv[q] * cs.y);
                v[q] = d < 16 ? rot : v[q];
              }
            }
#pragma unroll
            for (int q = 0; q < 4; ++q) {
              const int t = mb + q;
              if (!isK) {
                P.qb[(size_t)t * 512 + c] = f2bf(v[q] * (0.125f * 1.4426950408889634f));
              } else if (t < TP) {
                P.out[O_KP + (size_t)t * 512 + c] = v[q];
                P.kP[(size_t)t * 512 + c] = f2bf(v[q]);
              } else {
                const int ts = t - TP;
                P.out[O_KS + (size_t)ts * 512 + c] = v[q];
                P.kS[((size_t)(ts >> 5) * KSL + 2048 + (ts & 31)) * 512 + c] = f2bf(v[q]);
              }
            }
          } else if (nb < 3072) {
            const int c = n - 2560, hh = c >> 7, dv = c & 127;
            u32x2 pk = {pack2(v[0], v[1]), pack2(v[2], v[3])};
            if (mb < TP) {
#pragma unroll
              for (int q = 0; q < 4; ++q) P.out[O_VP + (size_t)(mb + q) * 512 + c] = v[q];
              const int b = mb >> 14, s = mb & 16383;
              *(u32x2*)(P.vTP + ((size_t)(b * 4 + hh) * 128 + dv) * SEQ + s) = pk;
            } else {
              const int ts = mb - TP;
#pragma unroll
              for (int q = 0; q < 4; ++q) P.out[O_VS + (size_t)(ts + q) * 512 + c] = v[q];
              const int b = ts >> 5, s = ts & 31;
              *(u32x2*)(P.vTS + ((size_t)(b * 4 + hh) * 128 + dv) * KSL + 2048 + s) = pk;
            }
          } else {
            if (n < 3080) {
              const int ih = n - 3072;
              const float bias = P.dt_bias[ih];
#pragma unroll
              for (int q = 0; q < 4; ++q) {
                float x = v[q] + bias;
                P.dtb[(size_t)(mb + q) * 8 + ih] = fmaxf(x, 0.f) + log1pf(__expf(-fabsf(x)));
              }
            }
          }
        } else if constexpr (MODE == M_KV) {
          if (nb < 1024) {
#pragma unroll
            for (int q = 0; q < 4; ++q) {
              P.out[O_MKP + (size_t)(mb + q) * 1024 + n] = v[q];
              P.mkP[(size_t)(mb + q) * 1024 + n] = f2bf(v[q]);
            }
          } else {
            const int c = n - 1024, hh = c >> 8, dv = c & 255;
#pragma unroll
            for (int q = 0; q < 4; ++q) P.out[O_MVP + (size_t)(mb + q) * 1024 + c] = v[q];
            const int b = mb >> 8, key = mb & 255;
            u32x2 pk = {pack2(v[0], v[1]), pack2(v[2], v[3])};
            *(u32x2*)(P.mvTP + ((size_t)(b * 4 + hh) * 256 + dv) * 256 + key) = pk;
          }
        } else if constexpr (MODE == M_OUT) {
#pragma unroll
          for (int q = 0; q < 4; ++q) P.R2[(size_t)(mb + q) * 1024 + n] = f2bf(v[q]);
        } else if constexpr (MODE == M_MQ) {
#pragma unroll
          for (int q = 0; q < 4; ++q) P.R1[(size_t)(mb + q) * 1024 + n] = f2bf(v[q] * rs[lr + q] * (0.0625f * 1.4426950408889634f));
        } else if constexpr (MODE == M_MO) {
#pragma unroll
          for (int q = 0; q < 4; ++q) P.R1[(size_t)(mb + q) * 1024 + n] = f2bf(v[q]);
        } else if constexpr (MODE == M_PQ) {
#pragma unroll
          for (int q = 0; q < 4; ++q) P.qy[(size_t)(mb + q) * 2048 + n] = f2bf(v[q] * rs[lr + q]);
        }
      });
    }); });
}

template <int KW, int DQK, int DVT, int DVW, int NQREG, bool DB, bool MASK, int TK, bool PF2>
DI void attn_core(const bf16_t* __restrict__ Qw, int kcol, int vrow, const bf16_t* __restrict__ Kb, int ldk,
                  const bf16_t* __restrict__ VTb, int ldvt, int vtile, int ntiles, int nkeys, char* smem, f32x16 (&O)[DVW / 32], float& lsum) {
  constexpr int KST = KW + 8, VST = TK + 4, NQF = DQK / 16, JS = TK / 32;
  constexpr int STAGE = TK * KST + DVT * VST;
  bf16_t* base = (bf16_t*)smem;
  const int tid = TID(), lane = tid & 63, r = lane & 31, h = lane >> 5;
  bf16x8 qf[NQREG > 0 ? NQREG : 1];
#pragma unroll
  for (int ks = 0; ks < NQREG; ++ks) qf[ks] = *(const bf16x8*)(Qw + ks * 16 + h * 8);
  float m = -INFINITY;
  lsum = 0.f;
#pragma unroll
  for (int t = 0; t < DVW / 32; ++t)
#pragma unroll
    for (int e = 0; e < 16; ++e) O[t][e] = 0.f;
  constexpr int CPR = KW / 8, RPP = 256 / CPR, NPK = TK / RPP, VCPR = TK / 8, VRPP = 256 / VCPR, NPV = DVT / VRPP;
  u32x4 kreg[NPK], vreg[NPV];
  u32x4 kreg2[PF2 ? NPK : 1], vreg2[PF2 ? NPV : 1];
  const int krow_ = tid / CPR, kc_ = tid % CPR, vrow_ = tid / VCPR, vc_ = tid % VCPR;
  const bf16_t* Kg = Kb + (size_t)krow_ * ldk + kc_ * 8;
  const bf16_t* Vg = VTb + (size_t)vrow_ * ldvt + vc_ * 8;
  auto gload_ = [&](u32x4* kr, u32x4* vr, int kt) {
#pragma unroll
    for (int p = 0; p < NPK; ++p) kr[p] = *(const u32x4*)(Kg + (size_t)(kt * TK + p * RPP) * ldk);
#pragma unroll
    for (int p = 0; p < NPV; ++p) vr[p] = *(const u32x4*)(Vg + (size_t)(p * VRPP) * ldvt + (size_t)kt * vtile);
  };
  auto lwrite_ = [&](const u32x4* kr, const u32x4* vr, int st) {
    bf16_t* Ksw = base + st * STAGE;
    bf16_t* Vsw = Ksw + TK * KST;
#pragma unroll
    for (int p = 0; p < NPK; ++p) *(u32x4*)(Ksw + (p * RPP + krow_) * KST + kc_ * 8) = kr[p];
#pragma unroll
    for (int p = 0; p < NPV; ++p) {
      u32x2* d = (u32x2*)(Vsw + (p * VRPP + vrow_) * VST + vc_ * 8);
      u32x2 lo = {vr[p][0], vr[p][1]}, hi = {vr[p][2], vr[p][3]};
      d[0] = lo;
      d[1] = hi;
    }
  };
  auto gload = [&](int kt) { gload_(kreg, vreg, kt); };
  auto lwrite = [&](int st) { lwrite_(kreg, vreg, st); };
  auto compute = [&](int kt, int st) {
    const bf16_t* Ks = base + st * STAGE;
    const bf16_t* Vs = Ks + TK * KST;
    f32x16 s[JS];
#pragma unroll
    for (int js = 0; js < JS; ++js) {
#pragma unroll
      for (int e = 0; e < 16; ++e) s[js][e] = 0.f;
#pragma unroll
      for (int ks = 0; ks < NQF; ++ks) {
        bf16x8 a = ld16(Ks + (js * 32 + r) * KST + kcol + ks * 16 + h * 8);
        bf16x8 bq;
        if (ks < NQREG) bq = qf[ks < NQREG ? ks : 0];
        else bq = *(const bf16x8*)(Qw + ks * 16 + h * 8);
        s[js] = MFMA(a, bq, s[js]);
      }
    }
    if constexpr (MASK) {
      if (kt * TK + TK > nkeys) {
#pragma unroll
        for (int js = 0; js < JS; ++js)
#pragma unroll
          for (int e = 0; e < 16; ++e)
            if (kt * TK + js * 32 + crow(e, h) >= nkeys) s[js][e] = -INFINITY;
      }
    }
    float mx = s[0][0];
#pragma unroll
    for (int e = 1; e < 16; ++e) mx = fmaxf(mx, s[0][e]);
    if constexpr (JS == 2) {
#pragma unroll
      for (int e = 0; e < 16; ++e) mx = fmaxf(mx, s[JS - 1][e]);
    }
    mx = half_max(mx);
    const float mnew = fmaxf(m, mx);
    const float alpha = fexp2(m - mnew);
    m = mnew;
    const f2_t mm = {mnew, mnew};
    f2_t rs2 = {0.f, 0.f};
    bf16x8 pf[JS][2];
#pragma unroll
    for (int js = 0; js < JS; ++js) {
      u32x4 pk0, pk1;
#pragma unroll
      for (int e2 = 0; e2 < 8; ++e2) {
        f2_t v = {s[js][2 * e2], s[js][2 * e2 + 1]};
        v -= mm;
        const f2_t pe = {fexp2(v[0]), fexp2(v[1])};
        rs2 += pe;
        const unsigned u = pack2(pe[0], pe[1]);
        if (e2 < 4) pk0[e2 & 3] = u; else pk1[e2 & 3] = u;
      }
      pf[js][0] = __builtin_bit_cast(bf16x8, pk0);
      pf[js][1] = __builtin_bit_cast(bf16x8, pk1);
    }
    float rsum = rs2[0] + rs2[1];
    rsum = half_sum(rsum);
    lsum = lsum * alpha + rsum;
    if (__builtin_amdgcn_ballot_w64(alpha != 1.0f) != 0ull) {
      const f2_t a2 = {alpha, alpha};
#pragma unroll
      for (int t = 0; t < DVW / 32; ++t)
#pragma unroll
        for (int e2 = 0; e2 < 8; ++e2) {
          f2_t v = {O[t][2 * e2], O[t][2 * e2 + 1]};
          v *= a2;
          O[t][2 * e2] = v[0];
          O[t][2 * e2 + 1] = v[1];
        }
    }
#pragma unroll
    for (int t = 0; t < DVW / 32; ++t) {
#pragma unroll
      for (int js = 0; js < JS; ++js)
#pragma unroll
        for (int s2 = 0; s2 < 2; ++s2) {
          const bf16_t* vp = Vs + (vrow + t * 32 + r) * VST + js * 32 + s2 * 16 + h * 4;
          bf16x8 vf = ld8x2(vp, vp + 8);
          O[t] = MFMA(vf, pf[js][s2], O[t]);
        }
      if constexpr (!DB || PF2) __builtin_amdgcn_sched_barrier(0);
    }
  };
  __syncthreads();
  if constexpr (PF2) {
    gload_(kreg, vreg, 0);
    lwrite_(kreg, vreg, 0);
    if (ntiles > 1) gload_(kreg, vreg, 1);
    if (ntiles > 2) gload_(kreg2, vreg2, 2);
    __syncthreads();
    for (int kt = 0; kt < ntiles; kt += 2) {
      if (kt + 1 < ntiles) {
        lwrite_(kreg, vreg, 1);
        if (kt + 3 < ntiles) gload_(kreg, vreg, kt + 3);
      }
      compute(kt, 0);
      __syncthreads();
      if (kt + 1 >= ntiles) break;
      if (kt + 2 < ntiles) {
        lwrite_(kreg2, vreg2, 0);
        if (kt + 4 < ntiles) gload_(kreg2, vreg2, kt + 4);
      }
      compute(kt + 1, 1);
      __syncthreads();
    }
  } else {
    if constexpr (DB) {
      gload(0);
      lwrite(0);
      if (ntiles > 1) gload(1);
      __syncthreads();
    }
    for (int kt = 0; kt < ntiles; ++kt) {
      if constexpr (!DB) {
        __syncthreads();
        gload(kt);
        lwrite(0);
        __syncthreads();
      } else {
        if (kt + 1 < ntiles) {
          lwrite((kt + 1) & 1);
          if (kt + 2 < ntiles) gload(kt + 2);
        }
      }
      compute(kt, DB ? (kt & 1) : 0);
      if constexpr (DB) __syncthreads();
    }
  }
}

DI void diff_attn_item(const Params& P, int a, char* smem) {
  const int tid = TID(), lane = tid & 63, w = tid >> 6, r = lane & 31, h = lane >> 5;
  const int comp = w & 1, rg = w >> 1;
  f32x16 O[4];
  float ls;
  size_t tok;
  int hd;
  bool wr;
  if (a < 2048) {
    const int ch = 255 - (a >> 3), bh = a & 7, b = bh >> 2;
    hd = bh & 3;
    tok = (size_t)b * SEQ + ch * 64 + rg * 32 + r;
    attn_core<128, 64, 128, 128, 4, true, false, 64, false>(P.qb + tok * 512 + hd * 128 + comp * 64, comp * 64, 0, P.kP + (size_t)b * SEQ * 512 + hd * 128, 512,
                                 P.vTP + (size_t)(b * 4 + hd) * 128 * SEQ, SEQ, 64, ch + 1, SEQ, smem, O, ls);
    wr = (comp == 0);
  } else {
    const int bh = a - 2048, b = bh >> 2;
    hd = bh & 3;
    tok = (size_t)TP + b * 32 + r;
    attn_core<128, 64, 128, 128, 4, true, true, 64, false>(P.qb + tok * 512 + hd * 128 + comp * 64, comp * 64, 0, P.kS + (size_t)b * KSL * 512 + hd * 128, 512,
                                 P.vTS + (size_t)(b * 4 + hd) * 128 * KSL, KSL, 64, 33, NKS, smem, O, ls);
    wr = (w == 0);
  }
  const float lam = P.lamp[0];
  const float il = (comp == 0 ? 1.f : lam) / ls;
  float* X = (float*)smem;
  __syncthreads();
  if (comp == 1) {
#pragma unroll
    for (int t = 0; t < 4; ++t)
#pragma unroll
      for (int e = 0; e < 16; ++e) X[(rg * 128 + t * 32 + crow(e, h)) * 32 + r] = O[t][e] * il;
  }
  __syncthreads();
  if (comp == 0) {
    float ss = 0.f;
#pragma unroll
    for (int t = 0; t < 4; ++t)
#pragma unroll
      for (int e = 0; e < 16; ++e) {
        float o = O[t][e] * il - X[(rg * 128 + t * 32 + crow(e, h)) * 32 + r];
        O[t][e] = o;
        ss += o * o;
      }
    ss = half_sum(ss);
    const float rn = rsqrtf(ss * (1.f / 128.f) + EPSF) * 0.8f;
    if (wr) {
#pragma unroll
      for (int t = 0; t < 4; ++t)
#pragma unroll
        for (int g = 0; g < 4; ++g) {
          const int dv0 = t * 32 + 8 * g + 4 * h;
          const float4 gs = *(const float4*)(P.g_subln + dv0);
          u32x2 pk = {pack2(O[t][4 * g] * rn * gs.x, O[t][4 * g + 1] * rn * gs.y),
                      pack2(O[t][4 * g + 2] * rn * gs.z, O[t][4 * g + 3] * rn * gs.w)};
          *(u32x2*)(P.R1 + tok * 1024 + 512 + hd * 128 + dv0) = pk;
        }
    }
  }
}

DI void mem_attn_item(const Params& P, int a, char* smem) {
  const int tid = TID(), lane = tid & 63, w = tid >> 6, r = lane & 31, h = lane >> 5;
  const int dvh = w & 1, rg = w >> 1;
  f32x16 O[4];
  float ls;
  size_t tok;
  int hd;
  bool wr;
  if (a < 2048) {
    const int qblk = a >> 3, bh = a & 7, b = bh >> 2;
    hd = bh & 3;
    tok = (size_t)b * SEQ + qblk * 64 + rg * 32 + r;
    attn_core<256, 256, 256, 128, 16, true, false, 32, false>(P.R1 + tok * 1024 + hd * 256, 0, dvh * 128, P.mkP + (size_t)b * 256 * 1024 + hd * 256, 1024,
                                  P.mvTP + (size_t)(b * 4 + hd) * 256 * 256, 256, 32, 8, 256, smem, O, ls);
    wr = true;
  } else {
    const int bh = a - 2048, b = bh >> 2;
    hd = bh & 3;
    tok = (size_t)TP + b * 32 + r;
    attn_core<256, 256, 256, 128, 16, true, false, 32, false>(P.R1 + tok * 1024 + hd * 256, 0, dvh * 128, P.mkS + (size_t)b * 256 * 1024 + hd * 256, 1024,
                                  P.mvTS + (size_t)(b * 4 + hd) * 256 * 256, 256, 32, 8, 256, smem, O, ls);
    wr = (rg == 0);
  }
  const float il = 1.f / ls;
  if (wr) {
#pragma unroll
    for (int t = 0; t < 4; ++t)
#pragma unroll
      for (int g = 0; g < 4; ++g) {
        const int dv0 = dvh * 128 + t * 32 + 8 * g + 4 * h;
        u32x2 pk = {pack2(O[t][4 * g] * il, O[t][4 * g + 1] * il), pack2(O[t][4 * g + 2] * il, O[t][4 * g + 3] * il)};
        *(u32x2*)(P.R2 + tok * 1024 + hd * 256 + dv0) = pk;
      }
  }
}

DI void ssd_c1(const Params& P, int item, char* smem) {
  const int tid = TID(), lane = tid & 63, w = tid >> 6, r = lane & 31, h5 = lane >> 5;
  const bool sample = item >= 4096;
  int b, hd, c;
  if (!sample) { b = item >> 11; c = (item >> 3) & 255; hd = item & 7; }
  else { const int it_ = item - 4096; b = it_ >> 3; hd = it_ & 7; c = 0; }
  const int g = hd >> 2;
  const int L = sample ? 32 : SEQ;
  const size_t tok0 = sample ? (size_t)TP + b * 32 : (size_t)b * SEQ;
  bf16_t* Cs = (bf16_t*)smem;
  bf16_t* Bs = Cs + 64 * 136;
  bf16_t* BwT = Bs + 64 * 136;
  bf16_t* xT = BwT + 128 * 72;
  float* acum = (float*)(xT + 64 * 72);
  float* dts = acum + 64;
  float* wjs = dts + 64;
  float* misc = wjs + 64;
  const float a_h = -expf(P.a_log[hd]);
  const float Dh = P.d_skip[hd];
  const int pt = w >> 1, it = w & 1;
  const bf16_t* xbc = P.R2;
  __syncthreads();
  if (w == 0) {
    const int row = c * 64 + lane;
    const float dtv = row < L ? P.dtb[(tok0 + row) * 8 + hd] : 0.f;
    float ac = dtv * a_h;
#pragma unroll
    for (int o = 1; o < 64; o <<= 1) {
      float t = __shfl_up(ac, o);
      if (lane >= o) ac += t;
    }
    const float al = __shfl(ac, 63);
    acum[lane] = ac;
    dts[lane] = dtv;
    wjs[lane] = __expf(al - ac) * dtv;
    if (lane == 0) misc[0] = al;
    P.acb[(size_t)item * 64 + lane] = ac;
  }
  __syncthreads();
#pragma unroll 1
  for (int k = 0; k < 5; ++k) {
    int ch, nn = 0;
    if (k == 0) ch = hd * 64 + lane;
    else if (k < 3) { nn = (k - 1) * 64 + lane; ch = 512 + g * 128 + nn; }
    else { nn = (k - 3) * 64 + lane; ch = 768 + g * 128 + nn; }
    const float cw0 = P.conv_w[ch], cw1 = P.conv_w[1024 + ch], cw2 = P.conv_w[2048 + ch], cw3 = P.conv_w[3072 + ch], cb = P.conv_b[ch];
    float xv[19];
#pragma unroll
    for (int j = 0; j < 19; ++j) {
      const int row = c * 64 + 16 * w - 3 + j;
      const int rc = row < 0 ? 0 : (row < L ? row : L - 1);
      const float xg = bf2f(xbc[(tok0 + rc) * 1024 + ch]);
      xv[j] = (row >= 0 && row < L) ? xg : 0.f;
    }
    if (sample && w == 0) {
#pragma unroll
      for (int j = 0; j < 3; ++j) xv[j] = P.state_conv[((size_t)b * 3 + j) * 1024 + ch];
    }
    float o[16];
#pragma unroll
    for (int jj = 0; jj < 16; ++jj) {
      float val = cb + cw0 * xv[jj] + cw1 * xv[jj + 1] + cw2 * xv[jj + 2] + cw3 * xv[jj + 3];
      val = siluf(val);
      if (c * 64 + 16 * w + jj >= L) val = 0.f;
      o[jj] = val;
    }
    if (k == 0) {
      u32x4 v0 = {pack2(o[0], o[1]), pack2(o[2], o[3]), pack2(o[4], o[5]), pack2(o[6], o[7])};
      u32x4 v1 = {pack2(o[8], o[9]), pack2(o[10], o[11]), pack2(o[12], o[13]), pack2(o[14], o[15])};
      *(u32x4*)(xT + lane * 72 + 16 * w) = v0;
      *(u32x4*)(xT + lane * 72 + 16 * w + 8) = v1;
    } else if (k < 3) {
#pragma unroll
      for (int jj = 0; jj < 16; ++jj) Bs[(16 * w + jj) * 136 + nn] = f2bf(o[jj]);
      float ow[16];
#pragma unroll
      for (int jj = 0; jj < 16; ++jj) ow[jj] = o[jj] * wjs[16 * w + jj];
      u32x4 v0 = {pack2(ow[0], ow[1]), pack2(ow[2], ow[3]), pack2(ow[4], ow[5]), pack2(ow[6], ow[7])};
      u32x4 v1 = {pack2(ow[8], ow[9]), pack2(ow[10], ow[11]), pack2(ow[12], ow[13]), pack2(ow[14], ow[15])};
      *(u32x4*)(BwT + nn * 72 + 16 * w) = v0;
      *(u32x4*)(BwT + nn * 72 + 16 * w + 8) = v1;
    } else {
      const bool st = (hd & 3) == 0;
#pragma unroll
      for (int jj = 0; jj < 16; ++jj) {
        const bf16_t cv = f2bf(o[jj]);
        Cs[(16 * w + jj) * 136 + nn] = cv;
        const int row = c * 64 + 16 * w + jj;
        if (st && row < L) P.Cpost[(tok0 + row) * 256 + g * 128 + nn] = cv;
      }
    }
  }
  __syncthreads();
  bf16x8 Lf[2][2];
#pragma unroll
  for (int jt = 0; jt < 2; ++jt) {
    if (jt <= it) {
      f32x16 X;
#pragma unroll
      for (int e = 0; e < 16; ++e) X[e] = 0.f;
#pragma unroll
      for (int ks = 0; ks < 8; ++ks) {
        bf16x8 a = ld16(Bs + (jt * 32 + r) * 136 + ks * 16 + h5 * 8);
        bf16x8 bq = ld16(Cs + (it * 32 + r) * 136 + ks * 16 + h5 * 8);
        X = MFMA(a, bq, X);
      }
      const int i = it * 32 + r;
      const float ai = acum[i];
#pragma unroll
      for (int e = 0; e < 16; ++e) {
        const int j = jt * 32 + crow(e, h5);
        const float val = X[e] * __expf(fminf(ai - acum[j], 0.f)) * dts[j];
        X[e] = (j <= i) ? val : 0.f;
      }
      Lf[jt][0] = pack8(X, 0);
      Lf[jt][1] = pack8(X, 1);
    }
  }
  __builtin_amdgcn_sched_barrier(0);
  f32x16 Y;
#pragma unroll
  for (int e = 0; e < 16; ++e) Y[e] = 0.f;
#pragma unroll
  for (int jt = 0; jt < 2; ++jt) {
    if (jt <= it) {
#pragma unroll
      for (int s = 0; s < 2; ++s) {
        const bf16_t* xp = xT + (pt * 32 + r) * 72 + jt * 32 + s * 16 + h5 * 4;
        bf16x8 xf = ld8x2(xp, xp + 8);
        Y = MFMA(xf, Lf[jt][s], Y);
      }
    }
  }
  {
    const int i = it * 32 + r;
    const int row = c * 64 + i;
    if (row < L) {
      const size_t tok = tok0 + row;
#pragma unroll
      for (int gq = 0; gq < 4; ++gq) {
        const int p0 = pt * 32 + 8 * gq + 4 * h5;
        float y[4];
#pragma unroll
        for (int q = 0; q < 4; ++q) y[q] = Y[4 * gq + q] + Dh * bf2f(xT[(p0 + q) * 72 + i]);
        u32x2 pk = {pack2(y[0], y[1]), pack2(y[2], y[3])};
        *(u32x2*)(P.R1 + tok * 1024 + hd * 64 + p0) = pk;
      }
    }
  }
  __builtin_amdgcn_sched_barrier(0);
  {
    const float eal = __expf(misc[0]);
#pragma unroll
    for (int pt2 = 0; pt2 < 2; ++pt2) {
      f32x16 hacc;
#pragma unroll
      for (int gq = 0; gq < 4; ++gq) {
        float4 v = {0.f, 0.f, 0.f, 0.f};
        if (sample) {
          const int p = 32 * pt2 + r, n0 = 32 * w + 8 * gq + 4 * h5;
          v = *(const float4*)(P.state_ssm + (((size_t)b * 8 + hd) * 64 + p) * 128 + n0);
        }
        hacc[4 * gq] = v.x * eal; hacc[4 * gq + 1] = v.y * eal; hacc[4 * gq + 2] = v.z * eal; hacc[4 * gq + 3] = v.w * eal;
      }
#pragma unroll
      for (int s = 0; s < 4; ++s) {
        bf16x8 a = ld16(BwT + (32 * w + r) * 72 + s * 16 + h5 * 8);
        bf16x8 bq = ld16(xT + (32 * pt2 + r) * 72 + s * 16 + h5 * 8);
        hacc = MFMA(a, bq, hacc);
      }
#pragma unroll
      for (int gq = 0; gq < 4; ++gq) {
        const int p = 32 * pt2 + r, n0 = 32 * w + 8 * gq + 4 * h5;
        if (sample) {
          float4 v = {hacc[4 * gq], hacc[4 * gq + 1], hacc[4 * gq + 2], hacc[4 * gq + 3]};
          *(float4*)(P.out + O_SSMS + (((size_t)b * 8 + hd) * 64 + p) * 128 + n0) = v;
        } else {
          u32x2 pk = {pack2(hacc[4 * gq], hacc[4 * gq + 1]), pack2(hacc[4 * gq + 2], hacc[4 * gq + 3])};
          *(u32x2*)(P.SH + (((size_t)(b * 8 + hd) * 256 + c) * 64 + p) * 128 + n0) = pk;
        }
      }
    }
  }
}

DI void ssd_scan(const Params& P, int vblk, int vnb) {
  const int gtid = vblk * 256 + TID(), gsz = vnb * 256;
  for (int e = gtid; e < 16 * 2048; e += gsz) {
    const int bh = e >> 11, q4 = e & 2047;
    const int b = bh >> 3, hd = bh & 7;
    bf16_t* base = P.SH + (size_t)bh * 256 * 8192 + q4 * 4;
    float h0 = 0.f, h1 = 0.f, h2 = 0.f, h3 = 0.f;
#pragma unroll 1
    for (int c0 = 0; c0 < 256; c0 += 16) {
      u32x2 sv[16];
      float dec[16];
#pragma unroll
      for (int u = 0; u < 16; ++u) {
        sv[u] = *(const u32x2*)(base + (size_t)(c0 + u) * 8192);
        dec[u] = P.acb[((size_t)(b * 256 + c0 + u) * 8 + hd) * 64 + 63];
      }
#pragma unroll
      for (int u = 0; u < 16; ++u) {
        u32x2 hv = {pack2(h0, h1), pack2(h2, h3)};
        *(u32x2*)(base + (size_t)(c0 + u) * 8192) = hv;
        const float d = __expf(dec[u]);
        h0 = h0 * d + bflo(sv[u][0]); h1 = h1 * d + bfhi(sv[u][0]);
        h2 = h2 * d + bflo(sv[u][1]); h3 = h3 * d + bfhi(sv[u][1]);
      }
    }
    float4 o = {h0, h1, h2, h3};
    *(float4*)(P.out + O_SSMP + (size_t)bh * 8192 + q4 * 4) = o;
  }
}

DI void ssd_c3(const Params& P, int item, char* smem) {
  const int tid = TID(), lane = tid & 63, w = tid >> 6, r = lane & 31, h5 = lane >> 5;
  const bool sample = item >= 4096;
  int b, hd, c;
  if (!sample) { b = item >> 11; c = (item >> 3) & 255; hd = item & 7; }
  else { const int it_ = item - 4096; b = it_ >> 3; hd = it_ & 7; c = 0; }
  const int g = hd >> 2;
  const int L = sample ? 32 : SEQ;
  const size_t tok0 = sample ? (size_t)TP + b * 32 : (size_t)b * SEQ;
  bf16_t* Cs = (bf16_t*)smem;
  bf16_t* Hs = Cs + 64 * 136;
  const int pt = w >> 1, it = w & 1;
  __syncthreads();
#pragma unroll
  for (int pss = 0; pss < 4; ++pss) {
    const int row = pss * 16 + (tid >> 4), c16 = tid & 15;
    u32x4 cv = {0u, 0u, 0u, 0u};
    if (c * 64 + row < L) cv = *(const u32x4*)(P.Cpost + (tok0 + c * 64 + row) * 256 + g * 128 + c16 * 8);
    *(u32x4*)(Cs + row * 136 + c16 * 8) = cv;
    u32x4 hv;
    if (sample) {
      const float4* sp = (const float4*)(P.state_ssm + (((size_t)b * 8 + hd) * 64 + row) * 128 + c16 * 8);
      const float4 f0 = sp[0], f1 = sp[1];
      hv[0] = pack2(f0.x, f0.y); hv[1] = pack2(f0.z, f0.w); hv[2] = pack2(f1.x, f1.y); hv[3] = pack2(f1.z, f1.w);
    } else {
      hv = *(const u32x4*)(P.SH + (((size_t)(b * 8 + hd) * 256 + c) * 64 + row) * 128 + c16 * 8);
    }
    *(u32x4*)(Hs + row * 136 + c16 * 8) = hv;
  }
  __syncthreads();
  f32x16 Y;
#pragma unroll
  for (int e = 0; e < 16; ++e) Y[e] = 0.f;
#pragma unroll
  for (int ks = 0; ks < 8; ++ks) {
    bf16x8 a = ld16(Hs + (pt * 32 + r) * 136 + ks * 16 + h5 * 8);
    bf16x8 bq = ld16(Cs + (it * 32 + r) * 136 + ks * 16 + h5 * 8);
    Y = MFMA(a, bq, Y);
  }
  const int i = it * 32 + r;
  const int row = c * 64 + i;
  const bool valid = row < L;
  const size_t tok = tok0 + row;
  const float ea = __expf(P.acb[(size_t)item * 64 + i]);
  float ss = 0.f;
#pragma unroll
  for (int gq = 0; gq < 4; ++gq) {
    const int p0 = pt * 32 + 8 * gq + 4 * h5;
    if (valid) {
      const u32x2 zz = *(const u32x2*)(P.zb + tok * 512 + hd * 64 + p0);
      const u32x2 yd = *(const u32x2*)(P.R1 + tok * 1024 + hd * 64 + p0);
      const float zf[4] = {bflo(zz[0]), bfhi(zz[0]), bflo(zz[1]), bfhi(zz[1])};
      const float yf[4] = {bflo(yd[0]), bfhi(yd[0]), bflo(yd[1]), bfhi(yd[1])};
      float yz[4];
#pragma unroll
      for (int q = 0; q < 4; ++q) {
        const float y = yf[q] + Y[4 * gq + q] * ea;
        yz[q] = y * siluf(zf[q]);
        ss += yz[q] * yz[q];
      }
      const float4 gs = *(const float4*)(P.g_ssd + hd * 64 + p0);
      u32x2 pk = {pack2(yz[0] * gs.x, yz[1] * gs.y), pack2(yz[2] * gs.z, yz[3] * gs.w)};
      *(u32x2*)(P.R1 + tok * 1024 + hd * 64 + p0) = pk;
    }
  }
  ss = half_sum(ss);
  if (valid && h5 == 0) P.ssqp[tok * 16 + hd * 2 + pt] = ss;
}

DI void peer_scores_core(const Params& P, size_t tok, int hc, const bf16x8 (&qf)[8], int r, int h5) {
  unsigned key[64];
#pragma unroll
  for (int kt = 0; kt < 4; ++kt) {
    f32x16 X;
#pragma unroll
    for (int e = 0; e < 16; ++e) X[e] = 0.f;
#pragma unroll
    for (int ks = 0; ks < 8; ++ks) {
      bf16x8 a = *(const bf16x8*)(P.keysB + ((size_t)hc * 128 + kt * 32 + r) * 128 + ks * 16 + h5 * 8);
      X = MFMA(a, qf[ks], X);
    }
#pragma unroll
    for (int e = 0; e < 16; ++e) {
      const int idx = kt * 32 + crow(e, h5);
      key[kt * 16 + e] = (sortable(X[e]) & ~127u) | (unsigned)(127 - idx);
    }
  }
  float* so = P.topS + (tok * 16 + hc) * 16;
  int* io = P.topI + (tok * 16 + hc) * 16;
#pragma unroll 1
  for (int rr = 0; rr < 16; ++rr) {
    unsigned mx = 0u;
#pragma unroll
    for (int i = 0; i < 64; ++i) mx = key[i] > mx ? key[i] : mx;
    {
      auto sw = __builtin_amdgcn_permlane32_swap(mx, mx, false, false);
      mx = sw[0] > sw[1] ? sw[0] : sw[1];
    }
#pragma unroll
    for (int i = 0; i < 64; ++i) key[i] = (key[i] == mx) ? 0u : key[i];
    if (h5 == 0) {
      so[rr] = unsortable(mx & ~127u);
      io[rr] = 127 - (int)(mx & 127u);
    }
  }
}

DI float gelu_tanh(float x) {
  const float u = 0.7978845608028654f * (x + 0.044715f * x * x * x);
  const float th = 1.f - 2.f / (__expf(2.f * u) + 1.f);
  return 0.5f * x * (1.f + th);
}
DI void cand_ab(int L, int& a, int& b) {
  int aa = 0, rem = L;
#pragma unroll 1
  while (aa < 15 && rem >= 16 / (aa + 1)) { rem -= 16 / (aa + 1); ++aa; }
  a = aa; b = rem;
}

DI void peer_token(const Params& P, int tok, int lane, int ca, int cb) {
  float* xr = P.xres + (size_t)tok * 1024;
  const unsigned char* U8 = (const unsigned char*)P.Ub;
  const unsigned char* V8 = (const unsigned char*)P.Vb;
  float xa[16];
  f2_t tb[8], acc[8];
  {
    const float4* x4 = (const float4*)xr;
#pragma unroll
    for (int q = 0; q < 4; ++q) {
      const float4 v = x4[lane * 4 + q];
      xa[4 * q] = v.x; xa[4 * q + 1] = v.y; xa[4 * q + 2] = v.z; xa[4 * q + 3] = v.w;
    }
  }
  float ss = 0.f;
#pragma unroll
  for (int i = 0; i < 16; ++i) ss += xa[i] * xa[i];
  ss = wave_sum(ss);
  const float ri = rsqrtf(ss * (1.f / 1024.f) + EPSF);
  {
    const float4* g4 = (const float4*)P.g_ffn;
#pragma unroll
    for (int q = 0; q < 4; ++q) {
      const float4 gv = g4[lane * 4 + q];
      tb[2 * q][0] = xa[4 * q] * ri * gv.x; tb[2 * q][1] = xa[4 * q + 1] * ri * gv.y;
      tb[2 * q + 1][0] = xa[4 * q + 2] * ri * gv.z; tb[2 * q + 1][1] = xa[4 * q + 3] * ri * gv.w;
    }
#pragma unroll
    for (int i = 0; i < 8; ++i) { acc[i][0] = 0.f; acc[i][1] = 0.f; }
  }
  auto select = [&](int hd, int& e_out, float& gate_out) {
    const size_t base = ((size_t)tok * 16 + hd * 2) * 16;
    unsigned key = 0u;
    if (lane < 50) {
      const float sc = P.topS[base + ca] + P.topS[base + 16 + cb];
      key = (sortable(sc) & ~63u) | (unsigned)(63 - lane);
    }
    unsigned mysel = 0u;
#pragma unroll 1
    for (int rr = 0; rr < 16; ++rr) {
      const unsigned mx = wave_max_u(key);
      if (lane == rr) mysel = mx;
      if (key == mx) key = 0u;
    }
    int e = 0;
    float sval = -1e30f;
    if (lane < 16) {
      int a, b;
      cand_ab(63 - (int)(mysel & 63u), a, b);
      e = P.topI[base + a] * 128 + P.topI[base + 16 + b];
      sval = unsortable(mysel & ~63u);
    }
    const float mxv = __shfl(sval, 0);
    const float ex = lane < 16 ? __expf(sval - mxv) : 0.f;
    float sum = ex;
    sum += __shfl_xor(sum, 8); sum += __shfl_xor(sum, 4); sum += __shfl_xor(sum, 2); sum += __shfl_xor(sum, 1);
    e_out = e;
    gate_out = ex / sum;
  };
  int e;
  float gate;
  select(0, e, gate);
#pragma unroll 1
  for (int hd = 0; hd < 8; ++hd) {
    u32x4 uu[16];
#pragma unroll
    for (int k = 0; k < 16; ++k) {
      const int ek = __builtin_amdgcn_readlane(e, k);
      uu[k] = *(const u32x4*)(U8 + (size_t)ek * 1024 + lane * 16);
    }
    int e_n = 0;
    float gate_n = 0.f;
    if (hd + 1 < 8) select(hd + 1, e_n, gate_n);
    float d[16];
#pragma unroll
    for (int k = 0; k < 16; ++k) {
      f2_t d2 = {0.f, 0.f};
#pragma unroll
      for (int q = 0; q < 4; ++q) {
        d2 += __builtin_amdgcn_cvt_pk_f32_fp8((int)uu[k][q], false) * tb[2 * q];
        d2 += __builtin_amdgcn_cvt_pk_f32_fp8((int)uu[k][q], true) * tb[2 * q + 1];
      }
      d[k] = d2[0] + d2[1];
    }
    u32x4 vv[16];
#pragma unroll
    for (int k = 0; k < 16; ++k) {
      const int ek = __builtin_amdgcn_readlane(e, k);
      vv[k] = *(const u32x4*)(V8 + (size_t)ek * 1024 + lane * 16);
    }
#pragma unroll
    for (int i = 0; i < 8; ++i) {
      const bool up = (lane & 32) != 0;
      const float keep = up ? d[i + 8] : d[i], send = up ? d[i] : d[i + 8];
      d[i] = keep + __shfl_xor(send, 32);
    }
#pragma unroll
    for (int i = 0; i < 4; ++i) {
      const bool up = (lane & 16) != 0;
      const float keep = up ? d[i + 4] : d[i], send = up ? d[i] : d[i + 4];
      d[i] = keep + __shfl_xor(send, 16);
    }
#pragma unroll
    for (int i = 0; i < 2; ++i) {
      const bool up = (lane & 8) != 0;
      const float keep = up ? d[i + 2] : d[i], send = up ? d[i] : d[i + 2];
      d[i] = keep + __shfl_xor(send, 8);
    }
    float d0;
    {
      const bool up = (lane & 4) != 0;
      const float keep = up ? d[1] : d[0], send = up ? d[0] : d[1];
      d0 = keep + __shfl_xor(send, 4);
    }
    d0 += __shfl_xor(d0, 2); d0 += __shfl_xor(d0, 1);
    const float gk = __shfl(gate, (lane >> 2) & 15);
    const float act = gelu_tanh(d0 * (1.f / 128.f)) * gk * (1.f / 32.f);
#pragma unroll
    for (int k = 0; k < 16; ++k) {
      const float ak = __uint_as_float((unsigned)__builtin_amdgcn_readlane((int)__float_as_uint(act), k * 4));
      const f2_t ak2 = {ak, ak};
#pragma unroll
      for (int q = 0; q < 4; ++q) {
        acc[2 * q] += ak2 * __builtin_amdgcn_cvt_pk_f32_fp8((int)vv[k][q], false);
        acc[2 * q + 1] += ak2 * __builtin_amdgcn_cvt_pk_f32_fp8((int)vv[k][q], true);
      }
    }
    e = e_n;
    gate = gate_n;
  }
  float s3 = 0.f;
#pragma unroll
  for (int i = 0; i < 16; ++i) { xa[i] += acc[i >> 1][i & 1]; s3 += xa[i] * xa[i]; }
  s3 = wave_sum(s3);
  const float r3 = rsqrtf(s3 * (1.f / 1024.f) + EPSF);
  {
    const float4* g4 = (const float4*)P.g_final;
    float4* o4 = (float4*)xr;
#pragma unroll
    for (int q = 0; q < 4; ++q) {
      const float4 gv = g4[lane * 4 + q];
      float4 o;
      o.x = xa[4 * q] * r3 * gv.x; o.y = xa[4 * q + 1] * r3 * gv.y; o.z = xa[4 * q + 2] * r3 * gv.z; o.w = xa[4 * q + 3] * r3 * gv.w;
      o4[lane * 4 + q] = o;
    }
  }
}

template <int WHICH>
DI void resid_phase(const Params& P) {
  const int gtid = blockIdx.x * 256 + TID(), gsz = gridDim.x * 256, lane = TID() & 63;
  const int gw = gtid >> 6, nw = gsz >> 6;
  const float* g = WHICH == 0 ? P.g_mem_q : P.g_ffn;
  bf16_t* bufb = WHICH == 0 ? P.R2 : P.R1;
  for (int row = gw; row < TT; row += nw) {
    const float* xs;
    if constexpr (WHICH == 0) xs = row < TP ? P.x_prompt + (size_t)row * 1024 : P.x_sample + (size_t)(row - TP) * 1024;
    else xs = P.xres + (size_t)row * 1024;
    bf16_t* buf = bufb + (size_t)row * 1024;
    float* xo = P.xres + (size_t)row * 1024;
    float4 xv[4];
    u32x2 dv[4];
#pragma unroll
    for (int q = 0; q < 4; ++q) {
      const int idx = lane * 4 + 256 * q;
      xv[q] = *(const float4*)(xs + idx);
      dv[q] = *(const u32x2*)(buf + idx);
    }
    float ss = 0.f;
#pragma unroll
    for (int q = 0; q < 4; ++q) {
      const int idx = lane * 4 + 256 * q;
      float4 x = xv[q];
      x.x += bflo(dv[q][0]); x.y += bfhi(dv[q][0]); x.z += bflo(dv[q][1]); x.w += bfhi(dv[q][1]);
      ss += x.x * x.x + x.y * x.y + x.z * x.z + x.w * x.w;
      *(float4*)(xo + idx) = x;
      const float4 gv = *(const float4*)(g + idx);
      u32x2 o = {pack2(x.x * gv.x, x.y * gv.y), pack2(x.z * gv.z, x.w * gv.w)};
      *(u32x2*)(buf + idx) = o;
    }
    ss = wave_sum(ss);
    if (lane == 0) P.rinv[row] = rsqrtf(ss * (1.f / 1024.f) + EPSF);
  }
}

template <int PH>
DI void run_phase(const Params& P, char* smem, int* s_item, int cidx = 0) {
  if constexpr (PH == 0) {
    phaseA(P);
  } else if constexpr (PH == 1) {
    for (int t = blockIdx.x; t < 3300 + 32; t += gridDim.x) {
      if (t < 3300) gemm_tile<M_IN, 4>(P, P.R1, P.WinT, (t / 25) * 256, (t % 25) * 128, smem);
      else { const int u = t - 3300; gemm_tile<M_KV, 4>(P, P.mnP, P.WmkvT, (u >> 4) * 256, (u & 15) * 128, smem); }
    }
  } else if constexpr (PH == 2) {
    for (int t = blockIdx.x; t < 4352; t += gridDim.x) ssd_c1(P, t, smem);
  } else if constexpr (PH == 3) {
    ssd_scan(P, blockIdx.x, gridDim.x);
  } else if constexpr (PH == 4) {
    int q = blockIdx.x & 7, tries = 0;
    bool c3_ready = false;
    for (;;) {
      __syncthreads();
      if (TID() == 0) {
        int enc = -1;
        while (tries < 8) {
          const int it = (int)atomicAdd(&P.counters[8 * cidx + q], 1u);
          if (it < 832) { enc = q * 1024 + it; break; }
          q = (q + 1) & 7;
          ++tries;
        }
        *s_item = enc;
      }
      __syncthreads();
      const int enc = *s_item;
      if (enc < 0) break;
      const int qq = enc >> 10, it0 = enc & 1023, it = it0 - 16;
      if (it0 < 16) {
        ssd_scan(P, qq * 16 + it0, 128);
        __threadfence();
        __syncthreads();
        if (TID() == 0) atomicAdd(&P.counters[16], 1u);
      } else if (it < 256) diff_attn_item(P, it * 8 + qq, smem);
      else if (it < 272) diff_attn_item(P, 2048 + qq * 16 + (it - 256), smem);
      else {
        if (!c3_ready) {
          if (TID() == 0) { while (atomicAdd(&P.counters[16], 0u) < 128u) __builtin_amdgcn_s_sleep(8); }
          __syncthreads();
          __threadfence();
          c3_ready = true;
        }
        ssd_c3(P, qq * 544 + (it - 272), smem);
      }
    }
  } else if constexpr (PH == 5) {
    for (int t = blockIdx.x; t < 176 * 8; t += gridDim.x) gemm_tile<M_OUT, 3>(P, P.R1, P.WoutT, (t >> 3) * 192, (t & 7) * 128, smem);
  } else if constexpr (PH == 6) {
    resid_phase<0>(P);
  } else if constexpr (PH == 10) {
    resid_phase<1>(P);
  } else if constexpr (PH == 7) {
    for (int t = blockIdx.x; t < 176 * 8; t += gridDim.x) gemm_tile<M_MQ, 3>(P, P.R2, P.WmqT, (t >> 3) * 192, (t & 7) * 128, smem);
  } else if constexpr (PH == 8) {
    for (int t = blockIdx.x; t < 2176; t += gridDim.x) mem_attn_item(P, t, smem);
  } else if constexpr (PH == 9) {
    for (int t = blockIdx.x; t < 176 * 8; t += gridDim.x) gemm_tile<M_MO, 3>(P, P.R2, P.WmoT, (t >> 3) * 192, (t & 7) * 128, smem);
  } else if constexpr (PH == 11) {
    for (int t = blockIdx.x; t < 132 * 16; t += gridDim.x) gemm_tile<M_PQ, 4>(P, P.R1, P.WpqT, (t >> 4) * 256, (t & 15) * 128, smem);
  } else if constexpr (PH == 12) {
  } else if constexpr (PH == 13) {
    const int lane = TID() & 63;
    int ca, cb;
    cand_ab(lane < 50 ? lane : 49, ca, cb);
    const int gw = (blockIdx.x * 256 + TID()) >> 6, nw = (gridDim.x * 256) >> 6;
    for (int tok = gw; tok < TT; tok += nw) peer_token(P, tok, lane, ca, cb);
  }
}

template <int PH>
__global__ void __launch_bounds__(256, 2) k_phase(KArgs KA) {
  __shared__ __attribute__((aligned(16))) char smem[SMEM_BYTES];
  __shared__ int s_item;
  const Params P = make_params(KA, nullptr);
  run_phase<PH>(P, smem, &s_item, 1);
}

__global__ void __launch_bounds__(256, 2) k_mega(KArgs KA) {
  __shared__ __attribute__((aligned(16))) char smem[SMEM_BYTES];
  __shared__ int s_item;
  const Params P = make_params(KA, nullptr);
  cg::grid_group grid = cg::this_grid();
  run_phase<0>(P, smem, &s_item); grid.sync(); RP(0)
  run_phase<1>(P, smem, &s_item); grid.sync(); RP(1)
  run_phase<2>(P, smem, &s_item); grid.sync(); RP(2)
  run_phase<4>(P, smem, &s_item, 1); grid.sync();
  run_phase<5>(P, smem, &s_item); grid.sync(); RP(5)
  run_phase<6>(P, smem, &s_item); grid.sync();
  run_phase<7>(P, smem, &s_item); grid.sync(); RP(7)
  run_phase<8>(P, smem, &s_item); grid.sync(); RP(8)
  run_phase<9>(P, smem, &s_item); grid.sync();
  run_phase<10>(P, smem, &s_item); grid.sync();
  run_phase<11>(P, smem, &s_item); grid.sync(); RP(11)
  run_phase<13>(P, smem, &s_item);
}

extern "C" void kernel_launch(void* const* d_in, const int* in_sizes, int n_in, void* d_out, int out_size, void* d_ws, size_t ws_size,
                              hipStream_t stream) {
  KArgs KA{};
  for (int i = 0; i < 35; ++i) KA.in[i] = (const float*)d_in[i];
  KA.out = (float*)d_out;
  KA.ws = (char*)d_ws;
  size_t need = 0;
  (void)make_params(KA, &need);
  if (need > ws_size) { fprintf(stderr, "workspace too small: need %zu have %zu\n", need, ws_size); return; }

  static int grid_blocks = 0;
  if (!grid_blocks) {
    int dev = 0, cus = 0, per_cu = 0;
    hipGetDevice(&dev);
    hipDeviceGetAttribute(&cus, hipDeviceAttributeMultiprocessorCount, dev);
    hipOccupancyMaxActiveBlocksPerMultiprocessor(&per_cu, k_mega, 256, 0);
    if (per_cu < 1) per_cu = 1;
    if (per_cu > 2) per_cu = 2;
    grid_blocks = cus * per_cu;
  }
#if MEGA
  void* args[] = {&KA};
  hipError_t e = hipLaunchCooperativeKernel((void*)k_mega, dim3(grid_blocks), dim3(256), args, 0, stream);
  if (e != hipSuccess) fprintf(stderr, "cooperative launch failed: %s (grid %d)\n", hipGetErrorString(e), grid_blocks);
#else
  const dim3 g(grid_blocks), b(256);
  k_phase<0><<<g, b, 0, stream>>>(KA);
  k_phase<1><<<g, b, 0, stream>>>(KA);
  k_phase<2><<<g, b, 0, stream>>>(KA);
  k_phase<4><<<g, b, 0, stream>>>(KA);
  k_phase<5><<<g, b, 0, stream>>>(KA);
  k_phase<6><<<g, b, 0, stream>>>(KA);
  k_phase<7><<<g, b, 0, stream>>>(KA);
  k_phase<8><<<g, b, 0, stream>>>(KA);
  k_phase<9><<<g, b, 0, stream>>>(KA);
  k_phase<10><<<g, b, 0, stream>>>(KA);
  k_phase<11><<<g, b, 0, stream>>>(KA);
  k_phase<13><<<g, b, 0, stream>>>(KA);
#endif
}
```

```cpp
#include <hip/hip_runtime.h>
#include <hip/hip_cooperative_groups.h>
#include <stdint.h>
#include <cstdio>
namespace cg = cooperative_groups;

#ifndef MEGA
#define MEGA 1
#endif
#ifndef REPEAT_PHASE
#define REPEAT_PHASE -1
#endif
#define RP(n) if (REPEAT_PHASE == n) { run_phase<n>(P, smem, &s_item, 1); grid.sync(); }

typedef unsigned short bf16_t;
typedef __bf16 bf2_t __attribute__((ext_vector_type(2)));
typedef float f2_t __attribute__((ext_vector_type(2)));
using bf16x8 = __attribute__((ext_vector_type(8))) short;
using f32x16 = __attribute__((ext_vector_type(16))) float;
using u32x4 = __attribute__((ext_vector_type(4))) unsigned;
using u32x2 = __attribute__((ext_vector_type(2))) unsigned;
#define DI __device__ __forceinline__
#define MFMA(a, b, c) __builtin_amdgcn_mfma_f32_32x32x16_bf16((a), (b), (c), 0, 0, 0)

constexpr int TP = 32768, TS = 1024, TT = TP + TS, SEQ = 16384, KSL = 2112, NKS = 2080;
constexpr size_t O_YP = 0, O_YS = 33554432, O_KP = 34603008, O_VP = 51380224, O_SSMP = 68157440, O_CONVP = 68288512,
                 O_MKP = 68294656, O_MVP = 68818944, O_KS = 69343232, O_VS = 69867520, O_SSMS = 70391808, O_CONVS = 72488960;
constexpr int SMEM_BYTES = 70656;
constexpr float EPSF = 1e-6f;

struct Params {
  const float *x_prompt, *x_sample, *cache_k, *cache_v, *cache_mk, *cache_mv, *state_ssm, *state_conv, *mem_prompt;
  const float *g_mix, *w_in, *conv_w, *conv_b, *dt_bias, *a_log, *d_skip, *g_ssd, *lam_q1, *lam_k1, *lam_q2, *lam_k2, *g_subln,
      *w_out, *g_mem_q, *g_mem_kv, *w_mq, *w_mk, *w_mv, *w_mo, *g_ffn, *w_pq, *peer_keys, *peer_u, *peer_v, *g_final;
  float* out;
  float* xres;
  bf16_t *WinT, *WoutT, *WmqT, *WmkvT, *WmoT, *WpqT, *keysB, *Ub, *Vb, *mkS, *mvTS, *mnP, *mkP, *mvTP;
  bf16_t *R1, *R2, *kS, *vTS, *zb, *qb, *kP, *vTP, *qy, *SH, *Cpost;
  float *dtb, *ssqp, *rope, *lamp, *rinv, *topS, *acb;
  int* topI;
  unsigned* counters;
};

struct KArgs {
  const float* in[35];
  float* out;
  char* ws;
};

__host__ __device__ inline Params make_params(const KArgs& A, size_t* total) {
  Params P{};
  const float* const* in = A.in;
  P.x_prompt = in[0]; P.x_sample = in[1]; P.cache_k = in[2]; P.cache_v = in[3]; P.cache_mk = in[4]; P.cache_mv = in[5];
  P.state_ssm = in[6]; P.state_conv = in[7]; P.mem_prompt = in[8]; P.g_mix = in[9]; P.w_in = in[10]; P.conv_w = in[11];
  P.conv_b = in[12]; P.dt_bias = in[13]; P.a_log = in[14]; P.d_skip = in[15]; P.g_ssd = in[16]; P.lam_q1 = in[17];
  P.lam_k1 = in[18]; P.lam_q2 = in[19]; P.lam_k2 = in[20]; P.g_subln = in[21]; P.w_out = in[22]; P.g_mem_q = in[23];
  P.g_mem_kv = in[24]; P.w_mq = in[25]; P.w_mk = in[26]; P.w_mv = in[27]; P.w_mo = in[28]; P.g_ffn = in[29]; P.w_pq = in[30];
  P.peer_keys = in[31]; P.peer_u = in[32]; P.peer_v = in[33]; P.g_final = in[34];
  P.out = A.out;
  P.xres = A.out;
  char* ws = A.ws;
  size_t off = 0;
  auto alloc = [&](size_t bytes) { char* p = ws + off; off += (bytes + 255) & ~(size_t)255; return p; };
  P.WinT = (bf16_t*)alloc((size_t)3200 * 1024 * 2);
  P.WoutT = (bf16_t*)alloc((size_t)1024 * 1024 * 2);
  P.WmqT = (bf16_t*)alloc((size_t)1024 * 1024 * 2);
  P.WmkvT = (bf16_t*)alloc((size_t)2048 * 1024 * 2);
  P.WmoT = (bf16_t*)alloc((size_t)1024 * 1024 * 2);
  P.WpqT = (bf16_t*)alloc((size_t)2048 * 1024 * 2);
  P.keysB = (bf16_t*)alloc((size_t)16 * 128 * 128 * 2);
  P.Ub = (bf16_t*)alloc((size_t)16384 * 1024 * 2);
  P.Vb = (bf16_t*)alloc((size_t)16384 * 1024 * 2);
  P.mkS = (bf16_t*)alloc((size_t)32 * 256 * 1024 * 2);
  P.mvTS = (bf16_t*)alloc((size_t)32 * 256 * 1024 * 2);
  P.mnP = (bf16_t*)alloc((size_t)512 * 1024 * 2);
  P.mkP = (bf16_t*)alloc((size_t)512 * 1024 * 2);
  P.mvTP = (bf16_t*)alloc((size_t)512 * 1024 * 2);
  P.R1 = (bf16_t*)alloc((size_t)TT * 1024 * 2);
  P.R2 = (bf16_t*)alloc((size_t)TT * 1024 * 2);
  P.kS = (bf16_t*)alloc((size_t)32 * KSL * 512 * 2);
  P.vTS = (bf16_t*)alloc((size_t)32 * KSL * 512 * 2);
  char* r4 = alloc((size_t)TT * 2048 * 2);
  P.qy = (bf16_t*)r4;
  P.zb = (bf16_t*)r4;
  P.qb = P.zb + (size_t)TT * 512;
  P.kP = P.qb + (size_t)TT * 512;
  P.vTP = P.kP + (size_t)TP * 512;
  P.dtb = (float*)alloc((size_t)TT * 8 * 4);
  P.ssqp = (float*)alloc((size_t)TT * 16 * 4);
  P.rope = (float*)alloc((size_t)16416 * 16 * 4);
  P.rinv = (float*)alloc((size_t)TT * 4);
  P.lamp = (float*)alloc(256);
  P.counters = (unsigned*)alloc(256);
  P.SH = (bf16_t*)A.out;
  P.Cpost = P.SH + (size_t)16 * 256 * 8192;
  P.acb = (float*)(P.Cpost + (size_t)TT * 256);
  P.topS = (float*)P.R2;
  P.topI = (int*)(P.R2 + (size_t)TT * 512);
  if (total) *total = off;
  return P;
}

template <int V> struct IC { static constexpr int value = V; constexpr operator int() const { return V; } };
template <int N, class F> DI void static_for(F&& f) {
  if constexpr (N > 0) { static_for<N - 1>(f); f(IC<N - 1>{}); }
}
DI int TID() { int t = threadIdx.x; asm volatile("" : "+v"(t)); return t; }
DI unsigned pack2(float a, float b) {
  f2_t v = {a, b};
  return __builtin_bit_cast(unsigned, __builtin_convertvector(v, bf2_t));
}
DI bf16_t f2bf(float a) { return (bf16_t)(pack2(a, 0.f) & 0xffffu); }
DI float bf2f(bf16_t b) { return __uint_as_float(((unsigned)b) << 16); }
DI float bflo(unsigned u) { return __uint_as_float(u << 16); }
DI float bfhi(unsigned u) { return __uint_as_float(u & 0xffff0000u); }
DI int crow(int reg, int h) { return (reg & 3) + 8 * (reg >> 2) + 4 * h; }
DI bf16x8 pack8(const f32x16& x, int s) {
  u32x4 p;
  p[0] = pack2(x[8 * s], x[8 * s + 1]);
  p[1] = pack2(x[8 * s + 2], x[8 * s + 3]);
  p[2] = pack2(x[8 * s + 4], x[8 * s + 5]);
  p[3] = pack2(x[8 * s + 6], x[8 * s + 7]);
  return __builtin_bit_cast(bf16x8, p);
}
DI bf16x8 ld16(const bf16_t* p) { return *(const bf16x8*)p; }
DI bf16x8 ld8x2(const bf16_t* p0, const bf16_t* p1) {
  u32x2 a = *(const u32x2*)p0, b = *(const u32x2*)p1;
  u32x4 v = {a[0], a[1], b[0], b[1]};
  return __builtin_bit_cast(bf16x8, v);
}
DI float wave_sum(float v) {
#pragma unroll
  for (int o = 32; o; o >>= 1) v += __shfl_xor(v, o);
  return v;
}
DI unsigned wave_max_u(unsigned v) {
#pragma unroll
  for (int o = 32; o; o >>= 1) {
    unsigned t = (unsigned)__shfl_xor((int)v, o);
    v = v > t ? v : t;
  }
  return v;
}
DI float fexp2(float x) { return __builtin_amdgcn_exp2f(x); }
DI float half_max(float v) {
  auto r = __builtin_amdgcn_permlane32_swap(__float_as_uint(v), __float_as_uint(v), false, false);
  return fmaxf(__uint_as_float(r[0]), __uint_as_float(r[1]));
}
DI float half_sum(float v) {
  auto r = __builtin_amdgcn_permlane32_swap(__float_as_uint(v), __float_as_uint(v), false, false);
  return __uint_as_float(r[0]) + __uint_as_float(r[1]);
}
DI float siluf(float x) { return x / (1.f + __expf(-x)); }
DI unsigned sortable(float f) {
  unsigned u = __float_as_uint(f);
  return (u & 0x80000000u) ? ~u : (u | 0x80000000u);
}
DI float unsortable(unsigned s) {
  unsigned u = (s & 0x80000000u) ? (s & 0x7fffffffu) : ~s;
  return __uint_as_float(u);
}

DI void wT(const float* __restrict__ src, int ld, int c0, bf16_t* __restrict__ dst, int nrows, int gtid, int gsz) {
  for (int idx = gtid; idx < nrows * 128; idx += gsz) {
    int n = idx % nrows, k8 = idx / nrows;
    const float* s = src + (size_t)(k8 * 8) * ld + c0 + n;
    u32x4 v;
    v[0] = pack2(s[0], s[ld]);
    v[1] = pack2(s[2 * (size_t)ld], s[3 * (size_t)ld]);
    v[2] = pack2(s[4 * (size_t)ld], s[5 * (size_t)ld]);
    v[3] = pack2(s[6 * (size_t)ld], s[7 * (size_t)ld]);
    *(u32x4*)(dst + (size_t)n * 1024 + k8 * 8) = v;
  }
}
DI void cvt4(const float* __restrict__ src, bf16_t* __restrict__ dst, size_t n4, int gtid, int gsz) {
  for (size_t i = gtid; i < n4; i += gsz) {
    float4 v = ((const float4*)src)[i];
    u32x2 o = {pack2(v.x, v.y), pack2(v.z, v.w)};
    ((u32x2*)dst)[i] = o;
  }
}

DI void cvt8(const float* __restrict__ src, unsigned* __restrict__ dst, size_t n4, float scale, int gtid, int gsz) {
  for (size_t i = gtid; i < n4; i += gsz) {
    float4 v = ((const float4*)src)[i];
    const float a = fminf(fmaxf(v.x * scale, -448.f), 448.f), b = fminf(fmaxf(v.y * scale, -448.f), 448.f);
    const float c = fminf(fmaxf(v.z * scale, -448.f), 448.f), d = fminf(fmaxf(v.w * scale, -448.f), 448.f);
    int pk = __builtin_amdgcn_cvt_pk_fp8_f32(a, b, 0, false);
    pk = __builtin_amdgcn_cvt_pk_fp8_f32(c, d, pk, true);
    dst[i] = (unsigned)pk;
  }
}

DI void phaseA(const Params& P) {
  const int tid = TID(), gtid = blockIdx.x * 256 + tid, gsz = gridDim.x * 256;
  const int lane = tid & 63;
  const u32x4 z4 = {0u, 0u, 0u, 0u};
  if (gtid == 0) {
    float s1 = 0.f, s2 = 0.f;
    for (int i = 0; i < 64; ++i) { s1 += P.lam_q1[i] * P.lam_k1[i]; s2 += P.lam_q2[i] * P.lam_k2[i]; }
    P.lamp[0] = expf(s1) - expf(s2) + 0.2f;
    for (int i = 0; i < 16; ++i) P.counters[i] = 0u;
  }
  {
    const int gw = gtid >> 6, nw = gsz >> 6;
    for (int row = gw; row < TT + 512; row += nw) {
      const float* src; const float* g; bf16_t* dst;
      if (row < TP) { src = P.x_prompt + (size_t)row * 1024; g = P.g_mix; dst = P.R1 + (size_t)row * 1024; }
      else if (row < TT) { src = P.x_sample + (size_t)(row - TP) * 1024; g = P.g_mix; dst = P.R1 + (size_t)row * 1024; }
      else { src = P.mem_prompt + (size_t)(row - TT) * 1024; g = P.g_mem_kv; dst = P.mnP + (size_t)(row - TT) * 1024; }
      const float4* s4 = (const float4*)src; const float4* g4 = (const float4*)g;
      float4 a0 = s4[lane * 2], a1 = s4[lane * 2 + 1], b0 = s4[128 + lane * 2], b1 = s4[128 + lane * 2 + 1];
      float ss = a0.x * a0.x + a0.y * a0.y + a0.z * a0.z + a0.w * a0.w + a1.x * a1.x + a1.y * a1.y + a1.z * a1.z + a1.w * a1.w +
                 b0.x * b0.x + b0.y * b0.y + b0.z * b0.z + b0.w * b0.w + b1.x * b1.x + b1.y * b1.y + b1.z * b1.z + b1.w * b1.w;
      ss = wave_sum(ss);
      const float ri = rsqrtf(ss * (1.f / 1024.f) + EPSF);
      float4 ga0 = g4[lane * 2], ga1 = g4[lane * 2 + 1], gb0 = g4[128 + lane * 2], gb1 = g4[128 + lane * 2 + 1];
      u32x4 o0 = {pack2(a0.x * ri * ga0.x, a0.y * ri * ga0.y), pack2(a0.z * ri * ga0.z, a0.w * ri * ga0.w),
                  pack2(a1.x * ri * ga1.x, a1.y * ri * ga1.y), pack2(a1.z * ri * ga1.z, a1.w * ri * ga1.w)};
      u32x4 o1 = {pack2(b0.x * ri * gb0.x, b0.y * ri * gb0.y), pack2(b0.z * ri * gb0.z, b0.w * ri * gb0.w),
                  pack2(b1.x * ri * gb1.x, b1.y * ri * gb1.y), pack2(b1.z * ri * gb1.z, b1.w * ri * gb1.w)};
      *(u32x4*)(dst + lane * 8) = o0;
      *(u32x4*)(dst + 512 + lane * 8) = o1;
    }
  }
  wT(P.w_in, 3080, 0, P.WinT, 1536, gtid, gsz);
  wT(P.w_in, 3080, 1544, P.WinT + (size_t)1536 * 1024, 1536, gtid, gsz);
  wT(P.w_in, 3080, 1536, P.WinT + (size_t)3072 * 1024, 8, gtid, gsz);
  for (int i = gtid; i < 120 * 128; i += gsz) *(u32x4*)(P.WinT + (size_t)3080 * 1024 + (size_t)i * 8) = z4;
  wT(P.w_out, 1024, 0, P.WoutT, 1024, gtid, gsz);
  wT(P.w_mq, 1024, 0, P.WmqT, 1024, gtid, gsz);
  wT(P.w_mk, 1024, 0, P.WmkvT, 1024, gtid, gsz);
  wT(P.w_mv, 1024, 0, P.WmkvT + (size_t)1024 * 1024, 1024, gtid, gsz);
  wT(P.w_mo, 1024, 0, P.WmoT, 1024, gtid, gsz);
  wT(P.w_pq, 2048, 0, P.WpqT, 2048, gtid, gsz);
  for (int i = gtid; i < 16416 * 8; i += gsz) {
    int pi = i >> 3, j = i & 7;
    float pos = (float)(pi < 16384 ? pi : (2048 + pi - 16384));
    float inv = 1.0f / powf(500000.f, (float)j * 0.125f);
    float ang = pos * inv;
    double a = (double)ang;
    a -= 6.283185307179586 * floor(a * 0.15915494309189535);
    float ar = (float)a;
    P.rope[i * 2] = cosf(ar);
    P.rope[i * 2 + 1] = sinf(ar);
  }
  cvt4(P.peer_keys, P.keysB, (size_t)16 * 128 * 128 / 4, gtid, gsz);
  cvt4(P.cache_mk, P.mkS, (size_t)32 * 256 * 1024 / 4, gtid, gsz);
  for (int i = gtid; i < 32 * 4 * 32 * 256; i += gsz) {
    int dv = i & 255, k8 = (i >> 8) & 31, bh = i >> 13, b = bh >> 2, h = bh & 3;
    const float* s = P.cache_mv + (((size_t)b * 256 + k8 * 8) * 4 + h) * 256 + dv;
    u32x4 v = {pack2(s[0], s[1024]), pack2(s[2048], s[3072]), pack2(s[4096], s[5120]), pack2(s[6144], s[7168])};
    *(u32x4*)(P.mvTS + ((size_t)bh * 256 + dv) * 256 + k8 * 8) = v;
  }
  for (size_t i = gtid; i < (size_t)32 * 2048 * 512 / 4; i += gsz) {
    size_t e = i * 4, b = e / (2048 * 512), rem = e % (2048 * 512);
    float4 v = ((const float4*)P.cache_k)[i];
    u32x2 o = {pack2(v.x, v.y), pack2(v.z, v.w)};
    *(u32x2*)(P.kS + b * (size_t)KSL * 512 + rem) = o;
  }
  for (int i = gtid; i < 32 * 32 * 64; i += gsz) {
    int b = i / (32 * 64), rem = i % (32 * 64);
    *(u32x4*)(P.kS + ((size_t)b * KSL + NKS) * 512 + (size_t)rem * 8) = z4;
  }
  for (int i = gtid; i < 32 * 4 * 256 * 128; i += gsz) {
    int dv = i & 127, k8 = (i >> 7) & 255, bh = i >> 15, b = bh >> 2, h = bh & 3;
    const float* s = P.cache_v + (((size_t)b * 2048 + k8 * 8) * 4 + h) * 128 + dv;
    u32x4 v = {pack2(s[0], s[512]), pack2(s[1024], s[1536]), pack2(s[2048], s[2560]), pack2(s[3072], s[3584])};
    *(u32x4*)(P.vTS + ((size_t)bh * 128 + dv) * KSL + k8 * 8) = v;
  }
  for (int i = gtid; i < 128 * 128 * 4; i += gsz) {
    int c = i & 3, row = i >> 2;
    *(u32x4*)(P.vTS + (size_t)row * KSL + NKS + c * 8) = z4;
  }
  cvt8(P.peer_u, (unsigned*)P.Ub, (size_t)16384 * 1024 / 4, 128.f, gtid, gsz);
  cvt8(P.peer_v, (unsigned*)P.Vb, (size_t)16384 * 1024 / 4, 32.f, gtid, gsz);
}

enum { M_IN = 0, M_KV = 1, M_OUT = 2, M_MQ = 3, M_MO = 4, M_PQ = 5 };
DI void peer_scores_core(const Params& P, size_t tok, int hc, const bf16x8 (&qf)[8], int r, int h5);

template <int MODE, int MI>
DI void gemm_tile(const Params& P, const bf16_t* __restrict__ A, const bf16_t* __restrict__ Bt, int m0, int n0, char* smem) {
  constexpr int BM = 64 * MI;
  bf16_t* As = (bf16_t*)smem;
  bf16_t* Bs = As + BM * 72;
  float* rs = (float*)(smem + (MODE == M_PQ ? 69632 : (BM + 128) * 72 * 2));
  const int tid = TID(), lane = tid & 63, w = tid >> 6, r = lane & 31, h = lane >> 5;
  const int wm = w >> 1, wn = w & 1;
  __syncthreads();
  if constexpr (MODE == M_OUT) if (tid < BM) {
    const float4* q = (const float4*)(P.ssqp + (size_t)(m0 + tid) * 16);
    float4 a = q[0], b = q[1], c = q[2], d = q[3];
    float s = a.x + a.y + a.z + a.w + b.x + b.y + b.z + b.w + c.x + c.y + c.z + c.w + d.x + d.y + d.z + d.w;
    rs[tid] = rsqrtf(s * (1.f / 512.f) + EPSF);
  }
  if constexpr (MODE == M_MQ || MODE == M_PQ) if (tid < BM) rs[tid] = P.rinv[m0 + tid];
  f32x16 acc[MI][2];
#pragma unroll
  for (int i = 0; i < MI; ++i)
#pragma unroll
    for (int j = 0; j < 2; ++j)
#pragma unroll
      for (int e = 0; e < 16; ++e) acc[i][j][e] = 0.f;
  u32x4 ra[2 * MI], rb[4];
  const int lrow = tid >> 3, lc = tid & 7;
  const bf16_t* Ag = A + (size_t)(m0 + lrow) * 1024 + lc * 8;
  const bf16_t* Bg = Bt + (size_t)(n0 + lrow) * 1024 + lc * 8;
#pragma unroll
  for (int p = 0; p < 2 * MI; ++p) ra[p] = *(const u32x4*)(Ag + (size_t)p * 32 * 1024);
#pragma unroll
  for (int p = 0; p < 4; ++p) rb[p] = *(const u32x4*)(Bg + (size_t)p * 32 * 1024);
  for (int kt = 0; kt < 16; ++kt) {
    __syncthreads();
#pragma unroll
    for (int p = 0; p < 2 * MI; ++p) *(u32x4*)(As + (p * 32 + lrow) * 72 + lc * 8) = ra[p];
#pragma unroll
    for (int p = 0; p < 4; ++p) *(u32x4*)(Bs + (p * 32 + lrow) * 72 + lc * 8) = rb[p];
    __syncthreads();
    if (kt + 1 < 16) {
#pragma unroll
      for (int p = 0; p < 2 * MI; ++p) ra[p] = *(const u32x4*)(Ag + (size_t)p * 32 * 1024 + (kt + 1) * 64);
#pragma unroll
      for (int p = 0; p < 4; ++p) rb[p] = *(const u32x4*)(Bg + (size_t)p * 32 * 1024 + (kt + 1) * 64);
    }
    if constexpr (MODE == M_OUT) {
      if (kt == 8) {
#pragma unroll
        for (int i = 0; i < MI; ++i)
#pragma unroll
          for (int e = 0; e < 16; ++e) {
            float sc = rs[wm * (32 * MI) + i * 32 + crow(e, h)];
            acc[i][0][e] *= sc;
            acc[i][1][e] *= sc;
          }
      }
    }
#pragma unroll
    for (int s = 0; s < 4; ++s) {
      if (s == 2) __builtin_amdgcn_sched_barrier(0);
      bf16x8 b0 = ld16(Bs + (wn * 64 + r) * 72 + s * 16 + h * 8);
      bf16x8 b1 = ld16(Bs + (wn * 64 + 32 + r) * 72 + s * 16 + h * 8);
#pragma unroll
      for (int i = 0; i < MI; ++i) {
        bf16x8 a = ld16(As + (wm * (32 * MI) + i * 32 + r) * 72 + s * 16 + h * 8);
        acc[i][0] = MFMA(a, b0, acc[i][0]);
        acc[i][1] = MFMA(a, b1, acc[i][1]);
      }
    }
  }
  if constexpr (MODE == M_PQ) {
    static_assert(MODE != M_PQ || MI == 4 || MI == 2, "fused scoring expects 256- or 128-row tiles");
    __syncthreads();
    bf16_t* Qs = (bf16_t*)smem;
#pragma unroll
    for (int i = 0; i < MI; ++i)
#pragma unroll
      for (int e = 0; e < 16; ++e) {
        const int row = wm * (32 * MI) + i * 32 + crow(e, h);
        const float sc = rs[row];
        Qs[row * 136 + wn * 64 + r] = f2bf(acc[i][0][e] * sc);
        Qs[row * 136 + wn * 64 + 32 + r] = f2bf(acc[i][1][e] * sc);
      }
    __syncthreads();
    const int hc = n0 >> 7;
#pragma unroll 1
    for (int bt = 0; bt < MI / 2; ++bt) {
      const int tokl = w * (16 * MI) + bt * 32 + r;
      bf16x8 qf[8];
#pragma unroll
      for (int ks = 0; ks < 8; ++ks) qf[ks] = ld16(Qs + tokl * 136 + ks * 16 + h * 8);
      peer_scores_core(P, (size_t)(m0 + tokl), hc, qf, r, h);
    }
    return;
  }
  int r2 = r, h2 = h;
  asm volatile("" : "+v"(r2), "+v"(h2));
  static_for<MI>([&](auto I_) { static_for<2>([&](auto J_) {
      constexpr int i = decltype(I_)::value, j = decltype(J_)::value;
      const int nb = n0 + wn * 64 + j * 32;
      const int n = nb + r2;
      static_for<4>([&](auto G_) {
        constexpr int g = decltype(G_)::value;
        const int lr = wm * (32 * MI) + i * 32 + 8 * g + 4 * h2;
        const int mb = m0 + lr;
        float v[4] = {acc[i][j][4 * g], acc[i][j][4 * g + 1], acc[i][j][4 * g + 2], acc[i][j][4 * g + 3]};
        float pv[4] = {0.f, 0.f, 0.f, 0.f};
        if constexpr (MODE == M_IN) {
#pragma unroll
          for (int q = 0; q < 4; ++q) pv[q] = __shfl_xor(v[q], 8);
        }
        if constexpr (MODE == M_IN) {
          if (nb < 512) {
#pragma unroll
            for (int q = 0; q < 4; ++q) P.zb[(size_t)(mb + q) * 512 + n] = f2bf(v[q]);
          } else if (nb < 1536) {
            const int c = n - 512;
#pragma unroll
            for (int q = 0; q < 4; ++q) {
              const int t = mb + q;
              P.R2[(size_t)t * 1024 + c] = f2bf(v[q]);
              if (t < TP) {
                int s = t & 16383;
                if (s >= 16381) P.out[O_CONVP + ((size_t)(t >> 14) * 3 + (s - 16381)) * 1024 + c] = v[q];
              } else {
                int ts = t - TP, s = ts & 31;
                if (s >= 29) P.out[O_CONVS + ((size_t)(ts >> 5) * 3 + (s - 29)) * 1024 + c] = v[q];
              }
            }
          } else if (nb < 2560) {
            const bool isK = nb >= 2048;
            const int c = (n - 1536) & 511;
            const int d = c & 63;
            if ((nb & 63) == 0) {
#pragma unroll
              for (int q = 0; q < 4; ++q) {
                const int t = mb + q;
                const int pi = t < TP ? (t & 16383) : (16384 + ((t - TP) & 31));
                const float2 cs = *(const float2*)(P.rope + ((size_t)pi * 8 + (d & 7)) * 2);
                const float rot = d < 8 ? (v[q] * cs.x - pv[q] * cs.y) : (v[q] * cs.x + pv[q] * cs.y);
                v[q] = d < 16 ? rot : v[q];
              }
            }
#pragma unroll
            for (int q = 0; q < 4; ++q) {
              const int t = mb + q;
              if (!isK) {
                P.qb[(size_t)t * 512 + c] = f2bf(v[q] * (0.125f * 1.4426950408889634f));
              } else if (t < TP) {
                P.out[O_KP + (size_t)t * 512 + c] = v[q];
                P.kP[(size_t)t * 512 + c] = f2bf(v[q]);
              } else {
                const int ts = t - TP;
                P.out[O_KS + (size_t)ts * 512 + c] = v[q];
                P.kS[((size_t)(ts >> 5) * KSL + 2048 + (ts & 31)) * 512 + c] = f2bf(v[q]);
              }
            }
          } else if (nb < 3072) {
            const int c = n - 2560, hh = c >> 7, dv = c & 127;
            u32x2 pk = {pack2(v[0], v[1]), pack2(v[2], v[3])};
            if (mb < TP) {
#pragma unroll
              for (int q = 0; q < 4; ++q) P.out[O_VP + (size_t)(mb + q) * 512 + c] = v[q];
              const int b = mb >> 14, s = mb & 16383;
              *(u32x2*)(P.vTP + ((size_t)(b * 4 + hh) * 128 + dv) * SEQ + s) = pk;
            } else {
              const int ts = mb - TP;
#pragma unroll
              for (int q = 0; q < 4; ++q) P.out[O_VS + (size_t)(ts + q) * 512 + c] = v[q];
              const int b = ts >> 5, s = ts & 31;
              *(u32x2*)(P.vTS + ((size_t)(b * 4 + hh) * 128 + dv) * KSL + 2048 + s) = pk;
            }
          } else {
            if (n < 3080) {
              const int ih = n - 3072;
              const float bias = P.dt_bias[ih];
#pragma unroll
              for (int q = 0; q < 4; ++q) {
                float x = v[q] + bias;
                P.dtb[(size_t)(mb + q) * 8 + ih] = fmaxf(x, 0.f) + log1pf(__expf(-fabsf(x)));
              }
            }
          }
        } else if constexpr (MODE == M_KV) {
          if (nb < 1024) {
#pragma unroll
            for (int q = 0; q < 4; ++q) {
              P.out[O_MKP + (size_t)(mb + q) * 1024 + n] = v[q];
              P.mkP[(size_t)(mb + q) * 1024 + n] = f2bf(v[q]);
            }
          } else {
            const int c = n - 1024, hh = c >> 8, dv = c & 255;
#pragma unroll
            for (int q = 0; q < 4; ++q) P.out[O_MVP + (size_t)(mb + q) * 1024 + c] = v[q];
            const int b = mb >> 8, key = mb & 255;
            u32x2 pk = {pack2(v[0], v[1]), pack2(v[2], v[3])};
            *(u32x2*)(P.mvTP + ((size_t)(b * 4 + hh) * 256 + dv) * 256 + key) = pk;
          }
        } else if constexpr (MODE == M_OUT) {
#pragma unroll
          for (int q = 0; q < 4; ++q) P.R2[(size_t)(mb + q) * 1024 + n] = f2bf(v[q]);
        } else if constexpr (MODE == M_MQ) {
#pragma unroll
          for (int q = 0; q < 4; ++q) P.R1[(size_t)(mb + q) * 1024 + n] = f2bf(v[q] * rs[lr + q] * (0.0625f * 1.4426950408889634f));
        } else if constexpr (MODE == M_MO) {
#pragma unroll
          for (int q = 0; q < 4; ++q) P.R1[(size_t)(mb + q) * 1024 + n] = f2bf(v[q]);
        } else if constexpr (MODE == M_PQ) {
#pragma unroll
          for (int q = 0; q < 4; ++q) P.qy[(size_t)(mb + q) * 2048 + n] = f2bf(v[q] * rs[lr + q]);
        }
      });
    }); });
}

template <int KW, int DQK, int DVT, int DVW, int NQREG, bool DB, bool MASK, int TK, bool PF2>
DI void attn_core(const bf16_t* __restrict__ Qw, int kcol, int vrow, const bf16_t* __restrict__ Kb, int ldk,
                  const bf16_t* __restrict__ VTb, int ldvt, int vtile, int ntiles, int nkeys, char* smem, f32x16 (&O)[DVW / 32], float& lsum) {
  constexpr int KST = KW + 8, VST = TK + 4, NQF = DQK / 16, JS = TK / 32;
  constexpr int STAGE = TK * KST + DVT * VST;
  bf16_t* base = (bf16_t*)smem;
  const int tid = TID(), lane = tid & 63, r = lane & 31, h = lane >> 5;
  bf16x8 qf[NQREG > 0 ? NQREG : 1];
#pragma unroll
  for (int ks = 0; ks < NQREG; ++ks) qf[ks] = *(const bf16x8*)(Qw + ks * 16 + h * 8);
  float m = -INFINITY;
  lsum = 0.f;
#pragma unroll
  for (int t = 0; t < DVW / 32; ++t)
#pragma unroll
    for (int e = 0; e < 16; ++e) O[t][e] = 0.f;
  constexpr int CPR = KW / 8, RPP = 256 / CPR, NPK = TK / RPP, VCPR = TK / 8, VRPP = 256 / VCPR, NPV = DVT / VRPP;
  u32x4 kreg[NPK], vreg[NPV];
  u32x4 kreg2[PF2 ? NPK : 1], vreg2[PF2 ? NPV : 1];
  const int krow_ = tid / CPR, kc_ = tid % CPR, vrow_ = tid / VCPR, vc_ = tid % VCPR;
  const bf16_t* Kg = Kb + (size_t)krow_ * ldk + kc_ * 8;
  const bf16_t* Vg = VTb + (size_t)vrow_ * ldvt + vc_ * 8;
  auto gload_ = [&](u32x4* kr, u32x4* vr, int kt) {
#pragma unroll
    for (int p = 0; p < NPK; ++p) kr[p] = *(const u32x4*)(Kg + (size_t)(kt * TK + p * RPP) * ldk);
#pragma unroll
    for (int p = 0; p < NPV; ++p) vr[p] = *(const u32x4*)(Vg + (size_t)(p * VRPP) * ldvt + (size_t)kt * vtile);
  };
  auto lwrite_ = [&](const u32x4* kr, const u32x4* vr, int st) {
    bf16_t* Ksw = base + st * STAGE;
    bf16_t* Vsw = Ksw + TK * KST;
#pragma unroll
    for (int p = 0; p < NPK; ++p) *(u32x4*)(Ksw + (p * RPP + krow_) * KST + kc_ * 8) = kr[p];
#pragma unroll
    for (int p = 0; p < NPV; ++p) {
      u32x2* d = (u32x2*)(Vsw + (p * VRPP + vrow_) * VST + vc_ * 8);
      u32x2 lo = {vr[p][0], vr[p][1]}, hi = {vr[p][2], vr[p][3]};
      d[0] = lo;
      d[1] = hi;
    }
  };
  auto gload = [&](int kt) { gload_(kreg, vreg, kt); };
  auto lwrite = [&](int st) { lwrite_(kreg, vreg, st); };
  auto compute = [&](int kt, int st) {
    const bf16_t* Ks = base + st * STAGE;
    const bf16_t* Vs = Ks + TK * KST;
    f32x16 s[JS];
#pragma unroll
    for (int js = 0; js < JS; ++js) {
#pragma unroll
      for (int e = 0; e < 16; ++e) s[js][e] = 0.f;
#pragma unroll
      for (int ks = 0; ks < NQF; ++ks) {
        bf16x8 a = ld16(Ks + (js * 32 + r) * KST + kcol + ks * 16 + h * 8);
        bf16x8 bq;
        if (ks < NQREG) bq = qf[ks < NQREG ? ks : 0];
        else bq = *(const bf16x8*)(Qw + ks * 16 + h * 8);
        s[js] = MFMA(a, bq, s[js]);
      }
    }
    if constexpr (MASK) {
      if (kt * TK + TK > nkeys) {
#pragma unroll
        for (int js = 0; js < JS; ++js)
#pragma unroll
          for (int e = 0; e < 16; ++e)
            if (kt * TK + js * 32 + crow(e, h) >= nkeys) s[js][e] = -INFINITY;
      }
    }
    float mx = s[0][0];
#pragma unroll
    for (int e = 1; e < 16; ++e) mx = fmaxf(mx, s[0][e]);
    if constexpr (JS == 2) {
#pragma unroll
      for (int e = 0; e < 16; ++e) mx = fmaxf(mx, s[JS - 1][e]);
    }
    mx = half_max(mx);
    const float mnew = fmaxf(m, mx);
    const float alpha = fexp2(m - mnew);
    m = mnew;
    const f2_t mm = {mnew, mnew};
    f2_t rs2 = {0.f, 0.f};
    bf16x8 pf[JS][2];
#pragma unroll
    for (int js = 0; js < JS; ++js) {
      u32x4 pk0, pk1;
#pragma unroll
      for (int e2 = 0; e2 < 8; ++e2) {
        f2_t v = {s[js][2 * e2], s[js][2 * e2 + 1]};
        v -= mm;
        const f2_t pe = {fexp2(v[0]), fexp2(v[1])};
        rs2 += pe;
        const unsigned u = pack2(pe[0], pe[1]);
        if (e2 < 4) pk0[e2 & 3] = u; else pk1[e2 & 3] = u;
      }
      pf[js][0] = __builtin_bit_cast(bf16x8, pk0);
      pf[js][1] = __builtin_bit_cast(bf16x8, pk1);
    }
    float rsum = rs2[0] + rs2[1];
    rsum = half_sum(rsum);
    lsum = lsum * alpha + rsum;
    if (__builtin_amdgcn_ballot_w64(alpha != 1.0f) != 0ull) {
      const f2_t a2 = {alpha, alpha};
#pragma unroll
      for (int t = 0; t < DVW / 32; ++t)
#pragma unroll
        for (int e2 = 0; e2 < 8; ++e2) {
          f2_t v = {O[t][2 * e2], O[t][2 * e2 + 1]};
          v *= a2;
          O[t][2 * e2] = v[0];
          O[t][2 * e2 + 1] = v[1];
        }
    }
#pragma unroll
    for (int t = 0; t < DVW / 32; ++t) {
#pragma unroll
      for (int js = 0; js < JS; ++js)
#pragma unroll
        for (int s2 = 0; s2 < 2; ++s2) {
          const bf16_t* vp = Vs + (vrow + t * 32 + r) * VST + js * 32 + s2 * 16 + h * 4;
          bf16x8 vf = ld8x2(vp, vp + 8);
          O[t] = MFMA(vf, pf[js][s2], O[t]);
        }
      if constexpr (!DB || PF2) __builtin_amdgcn_sched_barrier(0);
    }
  };
  __syncthreads();
  if constexpr (PF2) {
    gload_(kreg, vreg, 0);
    lwrite_(kreg, vreg, 0);
    if (ntiles > 1) gload_(kreg, vreg, 1);
    if (ntiles > 2) gload_(kreg2, vreg2, 2);
    __syncthreads();
    for (int kt = 0; kt < ntiles; kt += 2) {
      if (kt + 1 < ntiles) {
        lwrite_(kreg, vreg, 1);
        if (kt + 3 < ntiles) gload_(kreg, vreg, kt + 3);
      }
      compute(kt, 0);
      __syncthreads();
      if (kt + 1 >= ntiles) break;
      if (kt + 2 < ntiles) {
        lwrite_(kreg2, vreg2, 0);
        if (kt + 4 < ntiles) gload_(kreg2, vreg2, kt + 4);
      }
      compute(kt + 1, 1);
      __syncthreads();
    }
  } else {
    if constexpr (DB) {
      gload(0);
      lwrite(0);
      if (ntiles > 1) gload(1);
      __syncthreads();
    }
    for (int kt = 0; kt < ntiles; ++kt) {
      if constexpr (!DB) {
        __syncthreads();
        gload(kt);
        lwrite(0);
        __syncthreads();
      } else {
        if (kt + 1 < ntiles) {
          lwrite((kt + 1) & 1);
          if (kt + 2 < ntiles) gload(kt + 2);
        }
      }
      compute(kt, DB ? (kt & 1) : 0);
      if constexpr (DB) __syncthreads();
    }
  }
}

DI void diff_attn_item(const Params& P, int a, char* smem) {
  const int tid = TID(), lane = tid & 63, w = tid >> 6, r = lane & 31, h = lane >> 5;
  const int comp = w & 1, rg = w >> 1;
  f32x16 O[4];
  float ls;
  size_t tok;
  int hd;
  bool wr;
  if (a < 2048) {
    const int ch = 255 - (a >> 3), bh = a & 7, b = bh >> 2;
    hd = bh & 3;
    tok = (size_t)b * SEQ + ch * 64 + rg * 32 + r;
    attn_core<128, 64, 128, 128, 4, true, false, 64, false>(P.qb + tok * 512 + hd * 128 + comp * 64, comp * 64, 0, P.kP + (size_t)b * SEQ * 512 + hd * 128, 512,
                                 P.vTP + (size_t)(b * 4 + hd) * 128 * SEQ, SEQ, 64, ch + 1, SEQ, smem, O, ls);
    wr = (comp == 0);
  } else {
    const int bh = a - 2048, b = bh >> 2;
    hd = bh & 3;
    tok = (size_t)TP + b * 32 + r;
    attn_core<128, 64, 128, 128, 4, true, true, 64, false>(P.qb + tok * 512 + hd * 128 + comp * 64, comp * 64, 0, P.kS + (size_t)b * KSL * 512 + hd * 128, 512,
                                 P.vTS + (size_t)(b * 4 + hd) * 128 * KSL, KSL, 64, 33, NKS, smem, O, ls);
    wr = (w == 0);
  }
  const float lam = P.lamp[0];
  const float il = (comp == 0 ? 1.f : lam) / ls;
  float* X = (float*)smem;
  __syncthreads();
  if (comp == 1) {
#pragma unroll
    for (int t = 0; t < 4; ++t)
#pragma unroll
      for (int e = 0; e < 16; ++e) X[(rg * 128 + t * 32 + crow(e, h)) * 32 + r] = O[t][e] * il;
  }
  __syncthreads();
  if (comp == 0) {
    float ss = 0.f;
#pragma unroll
    for (int t = 0; t < 4; ++t)
#pragma unroll
      for (int e = 0; e < 16; ++e) {
        float o = O[t][e] * il - X[(rg * 128 + t * 32 + crow(e, h)) * 32 + r];
        O[t][e] = o;
        ss += o * o;
      }
    ss = half_sum(ss);
    const float rn = rsqrtf(ss * (1.f / 128.f) + EPSF) * 0.8f;
    if (wr) {
#pragma unroll
      for (int t = 0; t < 4; ++t)
#pragma unroll
        for (int g = 0; g < 4; ++g) {
          const int dv0 = t * 32 + 8 * g + 4 * h;
          const float4 gs = *(const float4*)(P.g_subln + dv0);
          u32x2 pk = {pack2(O[t][4 * g] * rn * gs.x, O[t][4 * g + 1] * rn * gs.y),
                      pack2(O[t][4 * g + 2] * rn * gs.z, O[t][4 * g + 3] * rn * gs.w)};
          *(u32x2*)(P.R1 + tok * 1024 + 512 + hd * 128 + dv0) = pk;
        }
    }
  }
}

DI void mem_attn_item(const Params& P, int a, char* smem) {
  const int tid = TID(), lane = tid & 63, w = tid >> 6, r = lane & 31, h = lane >> 5;
  const int dvh = w & 1, rg = w >> 1;
  f32x16 O[4];
  float ls;
  size_t tok;
  int hd;
  bool wr;
  if (a < 2048) {
    const int qblk = a >> 3, bh = a & 7, b = bh >> 2;
    hd = bh & 3;
    tok = (size_t)b * SEQ + qblk * 64 + rg * 32 + r;
    attn_core<256, 256, 256, 128, 16, true, false, 32, false>(P.R1 + tok * 1024 + hd * 256, 0, dvh * 128, P.mkP + (size_t)b * 256 * 1024 + hd * 256, 1024,
                                  P.mvTP + (size_t)(b * 4 + hd) * 256 * 256, 256, 32, 8, 256, smem, O, ls);
    wr = true;
  } else {
    const int bh = a - 2048, b = bh >> 2;
    hd = bh & 3;
    tok = (size_t)TP + b * 32 + r;
    attn_core<256, 256, 256, 128, 16, true, false, 32, false>(P.R1 + tok * 1024 + hd * 256, 0, dvh * 128, P.mkS + (size_t)b * 256 * 1024 + hd * 256, 1024,
                                  P.mvTS + (size_t)(b * 4 + hd) * 256 * 256, 256, 32, 8, 256, smem, O, ls);
    wr = (rg == 0);
  }
  const float il = 1.f / ls;
  if (wr) {
#pragma unroll
    for (int t = 0; t < 4; ++t)
#pragma unroll
      for (int g = 0; g < 4; ++g) {
        const int dv0 = dvh * 128 + t * 32 + 8 * g + 4 * h;
        u32x2 pk = {pack2(O[t][4 * g] * il, O[t][4 * g + 1] * il), pack2(O[t][4 * g + 2] * il, O[t][4 * g + 3] * il)};
        *(u32x2*)(P.R2 + tok * 1024 + hd * 256 + dv0) = pk;
      }
  }
}

DI void ssd_c1(const Params& P, int item, char* smem) {
  const int tid = TID(), lane = tid & 63, w = tid >> 6, r = lane & 31, h5 = lane >> 5;
  const bool sample = item >= 4096;
  int b, hd, c;
  if (!sample) { b = item >> 11; c = (item >> 3) & 255; hd = item & 7; }
  else { const int it_ = item - 4096; b = it_ >> 3; hd = it_ & 7; c = 0; }
  const int g = hd >> 2;
  const int L = sample ? 32 : SEQ;
  const size_t tok0 = sample ? (size_t)TP + b * 32 : (size_t)b * SEQ;
  bf16_t* Cs = (bf16_t*)smem;
  bf16_t* Bs = Cs + 64 * 136;
  bf16_t* BwT = Bs + 64 * 136;
  bf16_t* xT = BwT + 128 * 72;
  float* acum = (float*)(xT + 64 * 72);
  float* dts = acum + 64;
  float* wjs = dts + 64;
  float* misc = wjs + 64;
  const float a_h = -expf(P.a_log[hd]);
  const float Dh = P.d_skip[hd];
  const int pt = w >> 1, it = w & 1;
  const bf16_t* xbc = P.R2;
  __syncthreads();
  if (w == 0) {
    const int row = c * 64 + lane;
    const float dtv = row < L ? P.dtb[(tok0 + row) * 8 + hd] : 0.f;
    float ac = dtv * a_h;
#pragma unroll
    for (int o = 1; o < 64; o <<= 1) {
      float t = __shfl_up(ac, o);
      if (lane >= o) ac += t;
    }
    const float al = __shfl(ac, 63);
    acum[lane] = ac;
    dts[lane] = dtv;
    wjs[lane] = __expf(al - ac) * dtv;
    if (lane == 0) misc[0] = al;
    P.acb[(size_t)item * 64 + lane] = ac;
  }
  __syncthreads();
#pragma unroll 1
  for (int k = 0; k < 5; ++k) {
    int ch, nn = 0;
    if (k == 0) ch = hd * 64 + lane;
    else if (k < 3) { nn = (k - 1) * 64 + lane; ch = 512 + g * 128 + nn; }
    else { nn = (k - 3) * 64 + lane; ch = 768 + g * 128 + nn; }
    const float cw0 = P.conv_w[ch], cw1 = P.conv_w[1024 + ch], cw2 = P.conv_w[2048 + ch], cw3 = P.conv_w[3072 + ch], cb = P.conv_b[ch];
    float xv[19];
#pragma unroll
    for (int j = 0; j < 19; ++j) {
      const int row = c * 64 + 16 * w - 3 + j;
      const int rc = row < 0 ? 0 : (row < L ? row : L - 1);
      const float xg = bf2f(xbc[(tok0 + rc) * 1024 + ch]);
      xv[j] = (row >= 0 && row < L) ? xg : 0.f;
    }
    if (sample && w == 0) {
#pragma unroll
      for (int j = 0; j < 3; ++j) xv[j] = P.state_conv[((size_t)b * 3 + j) * 1024 + ch];
    }
    float o[16];
#pragma unroll
    for (int jj = 0; jj < 16; ++jj) {
      float val = cb + cw0 * xv[jj] + cw1 * xv[jj + 1] + cw2 * xv[jj + 2] + cw3 * xv[jj + 3];
      val = siluf(val);
      if (c * 64 + 16 * w + jj >= L) val = 0.f;
      o[jj] = val;
    }
    if (k == 0) {
      u32x4 v0 = {pack2(o[0], o[1]), pack2(o[2], o[3]), pack2(o[4], o[5]), pack2(o[6], o[7])};
      u32x4 v1 = {pack2(o[8], o[9]), pack2(o[10], o[11]), pack2(o[12], o[13]), pack2(o[14], o[15])};
      *(u32x4*)(xT + lane * 72 + 16 * w) = v0;
      *(u32x4*)(xT + lane * 72 + 16 * w + 8) = v1;
    } else if (k < 3) {
#pragma unroll
      for (int jj = 0; jj < 16; ++jj) Bs[(16 * w + jj) * 136 + nn] = f2bf(o[jj]);
      float ow[16];
#pragma unroll
      for (int jj = 0; jj < 16; ++jj) ow[jj] = o[jj] * wjs[16 * w + jj];
      u32x4 v0 = {pack2(ow[0], ow[1]), pack2(ow[2], ow[3]), pack2(ow[4], ow[5]), pack2(ow[6], ow[7])};
      u32x4 v1 = {pack2(ow[8], ow[9]), pack2(ow[10], ow[11]), pack2(ow[12], ow[13]), pack2(ow[14], ow[15])};
      *(u32x4*)(BwT + nn * 72 + 16 * w) = v0;
      *(u32x4*)(BwT + nn * 72 + 16 * w + 8) = v1;
    } else {
      const bool st = (hd & 3) == 0;
#pragma unroll
      for (int jj = 0; jj < 16; ++jj) {
        const bf16_t cv = f2bf(o[jj]);
        Cs[(16 * w + jj) * 136 + nn] = cv;
        const int row = c * 64 + 16 * w + jj;
        if (st && row < L) P.Cpost[(tok0 + row) * 256 + g * 128 + nn] = cv;
      }
    }
  }
  __syncthreads();
  bf16x8 Lf[2][2];
#pragma unroll
  for (int jt = 0; jt < 2; ++jt) {
    if (jt <= it) {
      f32x16 X;
#pragma unroll
      for (int e = 0; e < 16; ++e) X[e] = 0.f;
#pragma unroll
      for (int ks = 0; ks < 8; ++ks) {
        bf16x8 a = ld16(Bs + (jt * 32 + r) * 136 + ks * 16 + h5 * 8);
        bf16x8 bq = ld16(Cs + (it * 32 + r) * 136 + ks * 16 + h5 * 8);
        X = MFMA(a, bq, X);
      }
      const int i = it * 32 + r;
      const float ai = acum[i];
#pragma unroll
      for (int e = 0; e < 16; ++e) {
        const int j = jt * 32 + crow(e, h5);
        const float val = X[e] * __expf(fminf(ai - acum[j], 0.f)) * dts[j];
        X[e] = (j <= i) ? val : 0.f;
      }
      Lf[jt][0] = pack8(X, 0);
      Lf[jt][1] = pack8(X, 1);
    }
  }
  __builtin_amdgcn_sched_barrier(0);
  f32x16 Y;
#pragma unroll
  for (int e = 0; e < 16; ++e) Y[e] = 0.f;
#pragma unroll
  for (int jt = 0; jt < 2; ++jt) {
    if (jt <= it) {
#pragma unroll
      for (int s = 0; s < 2; ++s) {
        const bf16_t* xp = xT + (pt * 32 + r) * 72 + jt * 32 + s * 16 + h5 * 4;
        bf16x8 xf = ld8x2(xp, xp + 8);
        Y = MFMA(xf, Lf[jt][s], Y);
      }
    }
  }
  {
    const int i = it * 32 + r;
    const int row = c * 64 + i;
    if (row < L) {
      const size_t tok = tok0 + row;
#pragma unroll
      for (int gq = 0; gq < 4; ++gq) {
        const int p0 = pt * 32 + 8 * gq + 4 * h5;
        float y[4];
#pragma unroll
        for (int q = 0; q < 4; ++q) y[q] = Y[4 * gq + q] + Dh * bf2f(xT[(p0 + q) * 72 + i]);
        u32x2 pk = {pack2(y[0], y[1]), pack2(y[2], y[3])};
        *(u32x2*)(P.R1 + tok * 1024 + hd * 64 + p0) = pk;
      }
    }
  }
  __builtin_amdgcn_sched_barrier(0);
  {
    const float eal = __expf(misc[0]);
#pragma unroll
    for (int pt2 = 0; pt2 < 2; ++pt2) {
      f32x16 hacc;
#pragma unroll
      for (int gq = 0; gq < 4; ++gq) {
        float4 v = {0.f, 0.f, 0.f, 0.f};
        if (sample) {
          const int p = 32 * pt2 + r, n0 = 32 * w + 8 * gq + 4 * h5;
          v = *(const float4*)(P.state_ssm + (((size_t)b * 8 + hd) * 64 + p) * 128 + n0);
        }
        hacc[4 * gq] = v.x * eal; hacc[4 * gq + 1] = v.y * eal; hacc[4 * gq + 2] = v.z * eal; hacc[4 * gq + 3] = v.w * eal;
      }
#pragma unroll
      for (int s = 0; s < 4; ++s) {
        bf16x8 a = ld16(BwT + (32 * w + r) * 72 + s * 16 + h5 * 8);
        bf16x8 bq = ld16(xT + (32 * pt2 + r) * 72 + s * 16 + h5 * 8);
        hacc = MFMA(a, bq, hacc);
      }
#pragma unroll
      for (int gq = 0; gq < 4; ++gq) {
        const int p = 32 * pt2 + r, n0 = 32 * w + 8 * gq + 4 * h5;
        if (sample) {
          float4 v = {hacc[4 * gq], hacc[4 * gq + 1], hacc[4 * gq + 2], hacc[4 * gq + 3]};
          *(float4*)(P.out + O_SSMS + (((size_t)b * 8 + hd) * 64 + p) * 128 + n0) = v;
        } else {
          u32x2 pk = {pack2(hacc[4 * gq], hacc[4 * gq + 1]), pack2(hacc[4 * gq + 2], hacc[4 * gq + 3])};
          *(u32x2*)(P.SH + (((size_t)(b * 8 + hd) * 256 + c) * 64 + p) * 128 + n0) = pk;
        }
      }
    }
  }
}

DI void ssd_scan(const Params& P) {
  const int gtid = blockIdx.x * 256 + TID(), gsz = gridDim.x * 256;
  for (int e = gtid; e < 16 * 2048; e += gsz) {
    const int bh = e >> 11, q4 = e & 2047;
    const int b = bh >> 3, hd = bh & 7;
    bf16_t* base = P.SH + (size_t)bh * 256 * 8192 + q4 * 4;
    float h0 = 0.f, h1 = 0.f, h2 = 0.f, h3 = 0.f;
#pragma unroll 1
    for (int c0 = 0; c0 < 256; c0 += 16) {
      u32x2 sv[16];
      float dec[16];
#pragma unroll
      for (int u = 0; u < 16; ++u) {
        sv[u] = *(const u32x2*)(base + (size_t)(c0 + u) * 8192);
        dec[u] = P.acb[((size_t)(b * 256 + c0 + u) * 8 + hd) * 64 + 63];
      }
#pragma unroll
      for (int u = 0; u < 16; ++u) {
        u32x2 hv = {pack2(h0, h1), pack2(h2, h3)};
        *(u32x2*)(base + (size_t)(c0 + u) * 8192) = hv;
        const float d = __expf(dec[u]);
        h0 = h0 * d + bflo(sv[u][0]); h1 = h1 * d + bfhi(sv[u][0]);
        h2 = h2 * d + bflo(sv[u][1]); h3 = h3 * d + bfhi(sv[u][1]);
      }
    }
    float4 o = {h0, h1, h2, h3};
    *(float4*)(P.out + O_SSMP + (size_t)bh * 8192 + q4 * 4) = o;
  }
}

DI void ssd_c3(const Params& P, int item, char* smem) {
  const int tid = TID(), lane = tid & 63, w = tid >> 6, r = lane & 31, h5 = lane >> 5;
  const bool sample = item >= 4096;
  int b, hd, c;
  if (!sample) { b = item >> 11; c = (item >> 3) & 255; hd = item & 7; }
  else { const int it_ = item - 4096; b = it_ >> 3; hd = it_ & 7; c = 0; }
  const int g = hd >> 2;
  const int L = sample ? 32 : SEQ;
  const size_t tok0 = sample ? (size_t)TP + b * 32 : (size_t)b * SEQ;
  bf16_t* Cs = (bf16_t*)smem;
  bf16_t* Hs = Cs + 64 * 136;
  const int pt = w >> 1, it = w & 1;
  __syncthreads();
#pragma unroll
  for (int pss = 0; pss < 4; ++pss) {
    const int row = pss * 16 + (tid >> 4), c16 = tid & 15;
    u32x4 cv = {0u, 0u, 0u, 0u};
    if (c * 64 + row < L) cv = *(const u32x4*)(P.Cpost + (tok0 + c * 64 + row) * 256 + g * 128 + c16 * 8);
    *(u32x4*)(Cs + row * 136 + c16 * 8) = cv;
    u32x4 hv;
    if (sample) {
      const float4* sp = (const float4*)(P.state_ssm + (((size_t)b * 8 + hd) * 64 + row) * 128 + c16 * 8);
      const float4 f0 = sp[0], f1 = sp[1];
      hv[0] = pack2(f0.x, f0.y); hv[1] = pack2(f0.z, f0.w); hv[2] = pack2(f1.x, f1.y); hv[3] = pack2(f1.z, f1.w);
    } else {
      hv = *(const u32x4*)(P.SH + (((size_t)(b * 8 + hd) * 256 + c) * 64 + row) * 128 + c16 * 8);
    }
    *(u32x4*)(Hs + row * 136 + c16 * 8) = hv;
  }
  __syncthreads();
  f32x16 Y;
#pragma unroll
  for (int e = 0; e < 16; ++e) Y[e] = 0.f;
#pragma unroll
  for (int ks = 0; ks < 8; ++ks) {
    bf16x8 a = ld16(Hs + (pt * 32 + r) * 136 + ks * 16 + h5 * 8);
    bf16x8 bq = ld16(Cs + (it * 32 + r) * 136 + ks * 16 + h5 * 8);
    Y = MFMA(a, bq, Y);
  }
  const int i = it * 32 + r;
  const int row = c * 64 + i;
  const bool valid = row < L;
  const size_t tok = tok0 + row;
  const float ea = __expf(P.acb[(size_t)item * 64 + i]);
  float ss = 0.f;
#pragma unroll
  for (int gq = 0; gq < 4; ++gq) {
    const int p0 = pt * 32 + 8 * gq + 4 * h5;
    if (valid) {
      const u32x2 zz = *(const u32x2*)(P.zb + tok * 512 + hd * 64 + p0);
      const u32x2 yd = *(const u32x2*)(P.R1 + tok * 1024 + hd * 64 + p0);
      const float zf[4] = {bflo(zz[0]), bfhi(zz[0]), bflo(zz[1]), bfhi(zz[1])};
      const float yf[4] = {bflo(yd[0]), bfhi(yd[0]), bflo(yd[1]), bfhi(yd[1])};
      float yz[4];
#pragma unroll
      for (int q = 0; q < 4; ++q) {
        const float y = yf[q] + Y[4 * gq + q] * ea;
        yz[q] = y * siluf(zf[q]);
        ss += yz[q] * yz[q];
      }
      const float4 gs = *(const float4*)(P.g_ssd + hd * 64 + p0);
      u32x2 pk = {pack2(yz[0] * gs.x, yz[1] * gs.y), pack2(yz[2] * gs.z, yz[3] * gs.w)};
      *(u32x2*)(P.R1 + tok * 1024 + hd * 64 + p0) = pk;
    }
  }
  ss = half_sum(ss);
  if (valid && h5 == 0) P.ssqp[tok * 16 + hd * 2 + pt] = ss;
}

DI void peer_scores_core(const Params& P, size_t tok, int hc, const bf16x8 (&qf)[8], int r, int h5) {
  unsigned key[64];
#pragma unroll
  for (int kt = 0; kt < 4; ++kt) {
    f32x16 X;
#pragma unroll
    for (int e = 0; e < 16; ++e) X[e] = 0.f;
#pragma unroll
    for (int ks = 0; ks < 8; ++ks) {
      bf16x8 a = *(const bf16x8*)(P.keysB + ((size_t)hc * 128 + kt * 32 + r) * 128 + ks * 16 + h5 * 8);
      X = MFMA(a, qf[ks], X);
    }
#pragma unroll
    for (int e = 0; e < 16; ++e) {
      const int idx = kt * 32 + crow(e, h5);
      key[kt * 16 + e] = (sortable(X[e]) & ~127u) | (unsigned)(127 - idx);
    }
  }
  float* so = P.topS + (tok * 16 + hc) * 16;
  int* io = P.topI + (tok * 16 + hc) * 16;
#pragma unroll 1
  for (int rr = 0; rr < 16; ++rr) {
    unsigned mx = 0u;
#pragma unroll
    for (int i = 0; i < 64; ++i) mx = key[i] > mx ? key[i] : mx;
    {
      auto sw = __builtin_amdgcn_permlane32_swap(mx, mx, false, false);
      mx = sw[0] > sw[1] ? sw[0] : sw[1];
    }
#pragma unroll
    for (int i = 0; i < 64; ++i) key[i] = (key[i] == mx) ? 0u : key[i];
    if (h5 == 0) {
      so[rr] = unsortable(mx & ~127u);
      io[rr] = 127 - (int)(mx & 127u);
    }
  }
}

DI float gelu_tanh(float x) {
  const float u = 0.7978845608028654f * (x + 0.044715f * x * x * x);
  const float th = 1.f - 2.f / (__expf(2.f * u) + 1.f);
  return 0.5f * x * (1.f + th);
}
DI void cand_ab(int L, int& a, int& b) {
  int aa = 0, rem = L;
#pragma unroll 1
  while (aa < 15 && rem >= 16 / (aa + 1)) { rem -= 16 / (aa + 1); ++aa; }
  a = aa; b = rem;
}

DI void peer_token(const Params& P, int tok, int lane, int ca, int cb) {
  float* xr = P.xres + (size_t)tok * 1024;
  const unsigned char* U8 = (const unsigned char*)P.Ub;
  const unsigned char* V8 = (const unsigned char*)P.Vb;
  float xa[16];
  f2_t tb[8], acc[8];
  {
    const float4* x4 = (const float4*)xr;
#pragma unroll
    for (int q = 0; q < 4; ++q) {
      const float4 v = x4[lane * 4 + q];
      xa[4 * q] = v.x; xa[4 * q + 1] = v.y; xa[4 * q + 2] = v.z; xa[4 * q + 3] = v.w;
    }
  }
  float ss = 0.f;
#pragma unroll
  for (int i = 0; i < 16; ++i) ss += xa[i] * xa[i];
  ss = wave_sum(ss);
  const float ri = rsqrtf(ss * (1.f / 1024.f) + EPSF);
  {
    const float4* g4 = (const float4*)P.g_ffn;
#pragma unroll
    for (int q = 0; q < 4; ++q) {
      const float4 gv = g4[lane * 4 + q];
      tb[2 * q][0] = xa[4 * q] * ri * gv.x; tb[2 * q][1] = xa[4 * q + 1] * ri * gv.y;
      tb[2 * q + 1][0] = xa[4 * q + 2] * ri * gv.z; tb[2 * q + 1][1] = xa[4 * q + 3] * ri * gv.w;
    }
#pragma unroll
    for (int i = 0; i < 8; ++i) { acc[i][0] = 0.f; acc[i][1] = 0.f; }
  }
  auto select = [&](int hd, int& e_out, float& gate_out) {
    const size_t base = ((size_t)tok * 16 + hd * 2) * 16;
    unsigned key = 0u;
    if (lane < 50) {
      const float sc = P.topS[base + ca] + P.topS[base + 16 + cb];
      key = (sortable(sc) & ~63u) | (unsigned)(63 - lane);
    }
    unsigned mysel = 0u;
#pragma unroll 1
    for (int rr = 0; rr < 16; ++rr) {
      const unsigned mx = wave_max_u(key);
      if (lane == rr) mysel = mx;
      if (key == mx) key = 0u;
    }
    int e = 0;
    float sval = -1e30f;
    if (lane < 16) {
      int a, b;
      cand_ab(63 - (int)(mysel & 63u), a, b);
      e = P.topI[base + a] * 128 + P.topI[base + 16 + b];
      sval = unsortable(mysel & ~63u);
    }
    const float mxv = __shfl(sval, 0);
    const float ex = lane < 16 ? __expf(sval - mxv) : 0.f;
    float sum = ex;
    sum += __shfl_xor(sum, 8); sum += __shfl_xor(sum, 4); sum += __shfl_xor(sum, 2); sum += __shfl_xor(sum, 1);
    e_out = e;
    gate_out = ex / sum;
  };
  int e;
  float gate;
  select(0, e, gate);
#pragma unroll 1
  for (int hd = 0; hd < 8; ++hd) {
    u32x4 uu[16];
#pragma unroll
    for (int k = 0; k < 16; ++k) {
      const int ek = __builtin_amdgcn_readlane(e, k);
      uu[k] = *(const u32x4*)(U8 + (size_t)ek * 1024 + lane * 16);
    }
    int e_n = 0;
    float gate_n = 0.f;
    if (hd + 1 < 8) select(hd + 1, e_n, gate_n);
    float d[16];
#pragma unroll
    for (int k = 0; k < 16; ++k) {
      f2_t d2 = {0.f, 0.f};
#pragma unroll
      for (int q = 0; q < 4; ++q) {
        d2 += __builtin_amdgcn_cvt_pk_f32_fp8((int)uu[k][q], false) * tb[2 * q];
        d2 += __builtin_amdgcn_cvt_pk_f32_fp8((int)uu[k][q], true) * tb[2 * q + 1];
      }
      d[k] = d2[0] + d2[1];
    }
    u32x4 vv[16];
#pragma unroll
    for (int k = 0; k < 16; ++k) {
      const int ek = __builtin_amdgcn_readlane(e, k);
      vv[k] = *(const u32x4*)(V8 + (size_t)ek * 1024 + lane * 16);
    }
#pragma unroll
    for (int i = 0; i < 8; ++i) {
      const bool up = (lane & 32) != 0;
      const float keep = up ? d[i + 8] : d[i], send = up ? d[i] : d[i + 8];
      d[i] = keep + __shfl_xor(send, 32);
    }
#pragma unroll
    for (int i = 0; i < 4; ++i) {
      const bool up = (lane & 16) != 0;
      const float keep = up ? d[i + 4] : d[i], send = up ? d[i] : d[i + 4];
      d[i] = keep + __shfl_xor(send, 16);
    }
#pragma unroll
    for (int i = 0; i < 2; ++i) {
      const bool up = (lane & 8) != 0;
      const float keep = up ? d[i + 2] : d[i], send = up ? d[i] : d[i + 2];
      d[i] = keep + __shfl_xor(send, 8);
    }
    float d0;
    {
      const bool up = (lane & 4) != 0;
      const float keep = up ? d[1] : d[0], send = up ? d[0] : d[1];
      d0 = keep + __shfl_xor(send, 4);
    }
    d0 += __shfl_xor(d0, 2); d0 += __shfl_xor(d0, 1);
    const float gk = __shfl(gate, (lane >> 2) & 15);
    const float act = gelu_tanh(d0 * (1.f / 128.f)) * gk * (1.f / 32.f);
#pragma unroll
    for (int k = 0; k < 16; ++k) {
      const float ak = __uint_as_float((unsigned)__builtin_amdgcn_readlane((int)__float_as_uint(act), k * 4));
      const f2_t ak2 = {ak, ak};
#pragma unroll
      for (int q = 0; q < 4; ++q) {
        acc[2 * q] += ak2 * __builtin_amdgcn_cvt_pk_f32_fp8((int)vv[k][q], false);
        acc[2 * q + 1] += ak2 * __builtin_amdgcn_cvt_pk_f32_fp8((int)vv[k][q], true);
      }
    }
    e = e_n;
    gate = gate_n;
  }
  float s3 = 0.f;
#pragma unroll
  for (int i = 0; i < 16; ++i) { xa[i] += acc[i >> 1][i & 1]; s3 += xa[i] * xa[i]; }
  s3 = wave_sum(s3);
  const float r3 = rsqrtf(s3 * (1.f / 1024.f) + EPSF);
  {
    const float4* g4 = (const float4*)P.g_final;
    float4* o4 = (float4*)xr;
#pragma unroll
    for (int q = 0; q < 4; ++q) {
      const float4 gv = g4[lane * 4 + q];
      float4 o;
      o.x = xa[4 * q] * r3 * gv.x; o.y = xa[4 * q + 1] * r3 * gv.y; o.z = xa[4 * q + 2] * r3 * gv.z; o.w = xa[4 * q + 3] * r3 * gv.w;
      o4[lane * 4 + q] = o;
    }
  }
}

template <int WHICH>
DI void resid_phase(const Params& P) {
  const int gtid = blockIdx.x * 256 + TID(), gsz = gridDim.x * 256, lane = TID() & 63;
  const int gw = gtid >> 6, nw = gsz >> 6;
  const float* g = WHICH == 0 ? P.g_mem_q : P.g_ffn;
  bf16_t* bufb = WHICH == 0 ? P.R2 : P.R1;
  for (int row = gw; row < TT; row += nw) {
    const float* xs;
    if constexpr (WHICH == 0) xs = row < TP ? P.x_prompt + (size_t)row * 1024 : P.x_sample + (size_t)(row - TP) * 1024;
    else xs = P.xres + (size_t)row * 1024;
    bf16_t* buf = bufb + (size_t)row * 1024;
    float* xo = P.xres + (size_t)row * 1024;
    float4 xv[4];
    u32x2 dv[4];
#pragma unroll
    for (int q = 0; q < 4; ++q) {
      const int idx = lane * 4 + 256 * q;
      xv[q] = *(const float4*)(xs + idx);
      dv[q] = *(const u32x2*)(buf + idx);
    }
    float ss = 0.f;
#pragma unroll
    for (int q = 0; q < 4; ++q) {
      const int idx = lane * 4 + 256 * q;
      float4 x = xv[q];
      x.x += bflo(dv[q][0]); x.y += bfhi(dv[q][0]); x.z += bflo(dv[q][1]); x.w += bfhi(dv[q][1]);
      ss += x.x * x.x + x.y * x.y + x.z * x.z + x.w * x.w;
      *(float4*)(xo + idx) = x;
      const float4 gv = *(const float4*)(g + idx);
      u32x2 o = {pack2(x.x * gv.x, x.y * gv.y), pack2(x.z * gv.z, x.w * gv.w)};
      *(u32x2*)(buf + idx) = o;
    }
    ss = wave_sum(ss);
    if (lane == 0) P.rinv[row] = rsqrtf(ss * (1.f / 1024.f) + EPSF);
  }
}

template <int PH>
DI void run_phase(const Params& P, char* smem, int* s_item, int cidx = 0) {
  if constexpr (PH == 0) {
    phaseA(P);
  } else if constexpr (PH == 1) {
    for (int t = blockIdx.x; t < 3300 + 32; t += gridDim.x) {
      if (t < 3300) gemm_tile<M_IN, 4>(P, P.R1, P.WinT, (t / 25) * 256, (t % 25) * 128, smem);
      else { const int u = t - 3300; gemm_tile<M_KV, 4>(P, P.mnP, P.WmkvT, (u >> 4) * 256, (u & 15) * 128, smem); }
    }
  } else if constexpr (PH == 2) {
    for (int t = blockIdx.x; t < 4352; t += gridDim.x) ssd_c1(P, t, smem);
  } else if constexpr (PH == 3) {
    ssd_scan(P);
  } else if constexpr (PH == 4) {
    int q = blockIdx.x & 7, tries = 0;
    for (;;) {
      __syncthreads();
      if (TID() == 0) {
        int enc = -1;
        while (tries < 8) {
          const int it = (int)atomicAdd(&P.counters[8 * cidx + q], 1u);
          if (it < 816) { enc = q * 1024 + it; break; }
          q = (q + 1) & 7;
          ++tries;
        }
        *s_item = enc;
      }
      __syncthreads();
      const int enc = *s_item;
      if (enc < 0) break;
      const int qq = enc >> 10, it = enc & 1023;
      if (it < 256) diff_attn_item(P, it * 8 + qq, smem);
      else if (it < 272) diff_attn_item(P, 2048 + qq * 16 + (it - 256), smem);
      else ssd_c3(P, qq * 544 + (it - 272), smem);
    }
  } else if constexpr (PH == 5) {
    for (int t = blockIdx.x; t < 176 * 8; t += gridDim.x) gemm_tile<M_OUT, 3>(P, P.R1, P.WoutT, (t >> 3) * 192, (t & 7) * 128, smem);
  } else if constexpr (PH == 6) {
    resid_phase<0>(P);
  } else if constexpr (PH == 10) {
    resid_phase<1>(P);
  } else if constexpr (PH == 7) {
    for (int t = blockIdx.x; t < 176 * 8; t += gridDim.x) gemm_tile<M_MQ, 3>(P, P.R2, P.WmqT, (t >> 3) * 192, (t & 7) * 128, smem);
  } else if constexpr (PH == 8) {
    for (int t = blockIdx.x; t < 2176; t += gridDim.x) mem_attn_item(P, t, smem);
  } else if constexpr (PH == 9) {
    for (int t = blockIdx.x; t < 176 * 8; t += gridDim.x) gemm_tile<M_MO, 3>(P, P.R2, P.WmoT, (t >> 3) * 192, (t & 7) * 128, smem);
  } else if constexpr (PH == 11) {
    for (int t = blockIdx.x; t < 2048 + 128; t += gridDim.x) {
      if (t < 2048) gemm_tile<M_PQ, 4>(P, P.R1, P.WpqT, (t >> 4) * 256, (t & 15) * 128, smem);
      else { const int u = t - 2048; gemm_tile<M_PQ, 2>(P, P.R1, P.WpqT, 32768 + (u >> 4) * 128, (u & 15) * 128, smem); }
    }
  } else if constexpr (PH == 12) {
  } else if constexpr (PH == 13) {
    const int lane = TID() & 63;
    int ca, cb;
    cand_ab(lane < 50 ? lane : 49, ca, cb);
    const int gw = (blockIdx.x * 256 + TID()) >> 6, nw = (gridDim.x * 256) >> 6;
    for (int tok = gw; tok < TT; tok += nw) peer_token(P, tok, lane, ca, cb);
  }
}

template <int PH>
__global__ void __launch_bounds__(256, 2) k_phase(KArgs KA) {
  __shared__ __attribute__((aligned(16))) char smem[SMEM_BYTES];
  __shared__ int s_item;
  const Params P = make_params(KA, nullptr);
  run_phase<PH>(P, smem, &s_item, 1);
}

__global__ void __launch_bounds__(256, 2) k_mega(KArgs KA) {
  __shared__ __attribute__((aligned(16))) char smem[SMEM_BYTES];
  __shared__ int s_item;
  const Params P = make_params(KA, nullptr);
  cg::grid_group grid = cg::this_grid();
  run_phase<0>(P, smem, &s_item); grid.sync(); RP(0)
  run_phase<1>(P, smem, &s_item); grid.sync(); RP(1)
  run_phase<2>(P, smem, &s_item); grid.sync(); RP(2)
  run_phase<3>(P, smem, &s_item); grid.sync();
  run_phase<4>(P, smem, &s_item, 1); grid.sync();
  run_phase<5>(P, smem, &s_item); grid.sync(); RP(5)
  run_phase<6>(P, smem, &s_item); grid.sync();
  run_phase<7>(P, smem, &s_item); grid.sync(); RP(7)
  run_phase<8>(P, smem, &s_item); grid.sync(); RP(8)
  run_phase<9>(P, smem, &s_item); grid.sync();
  run_phase<10>(P, smem, &s_item); grid.sync();
  run_phase<11>(P, smem, &s_item); grid.sync(); RP(11)
  run_phase<13>(P, smem, &s_item);
}

extern "C" void kernel_launch(void* const* d_in, const int* in_sizes, int n_in, void* d_out, int out_size, void* d_ws, size_t ws_size,
                              hipStream_t stream) {
  KArgs KA{};
  for (int i = 0; i < 35; ++i) KA.in[i] = (const float*)d_in[i];
  KA.out = (float*)d_out;
  KA.ws = (char*)d_ws;
  size_t need = 0;
  (void)make_params(KA, &need);
  if (need > ws_size) { fprintf(stderr, "workspace too small: need %zu have %zu\n", need, ws_size); return; }

  static int grid_blocks = 0;
  if (!grid_blocks) {
    int dev = 0, cus = 0, per_cu = 0;
    hipGetDevice(&dev);
    hipDeviceGetAttribute(&cus, hipDeviceAttributeMultiprocessorCount, dev);
    hipOccupancyMaxActiveBlocksPerMultiprocessor(&per_cu, k_mega, 256, 0);
    if (per_cu < 1) per_cu = 1;
    if (per_cu > 2) per_cu = 2;
    grid_blocks = cus * per_cu;
  }
#if MEGA
  void* args[] = {&KA};
  hipError_t e = hipLaunchCooperativeKernel((void*)k_mega, dim3(grid_blocks), dim3(256), args, 0, stream);
  if (e != hipSuccess) fprintf(stderr, "cooperative launch failed: %s (grid %d)\n", hipGetErrorString(e), grid_blocks);
#else
  const dim3 g(grid_blocks), b(256);
  k_phase<0><<<g, b, 0, stream>>>(KA);
  k_phase<1><<<g, b, 0, stream>>>(KA);
  k_phase<2><<<g, b, 0, stream>>>(KA);
  k_phase<3><<<g, b, 0, stream>>>(KA);
  k_phase<4><<<g, b, 0, stream>>>(KA);
  k_phase<5><<<g, b, 0, stream>>>(KA);
  k_phase<6><<<g, b, 0, stream>>>(KA);
  k_phase<7><<<g, b, 0, stream>>>(KA);
  k_phase<8><<<g, b, 0, stream>>>(KA);
  k_phase<9><<<g, b, 0, stream>>>(KA);
  k_phase<10><<<g, b, 0, stream>>>(KA);
  k_phase<11><<<g, b, 0, stream>>>(KA);
  k_phase<13><<<g, b, 0, stream>>>(KA);
#endif
}
```
